# Optimizing an MI355X kernel written in HIP

```python
import jax, jax.numpy as jnp
from jax import lax
import numpy as np

D_MODEL = 1024
BATCH = 8
SEQ = 2048
DEPTH = 4
DEC_BATCH = 128
DEC_SEQ = 1
PAST_LEN = 16384
PAGE_SIZE = 128

N_MIXERS = 2
EXPAND = 2
D_INNER = EXPAND * D_MODEL
A_EXPAND_RATIO = 128
A_HEADS = D_MODEL // A_EXPAND_RATIO
A_DK = A_EXPAND_RATIO
A_DV = D_INNER // A_HEADS
A_CHUNK = 64
B_CHUNK = 128
B_GROUPS = 8
B_DG = D_INNER // B_GROUPS
PLE_DIM = 256
N_A = (DEPTH + 1) // 2
N_B = DEPTH // 2
EPS = 1e-6

kernel_name = "hgrn2_chunkmlp_hybrid_step"


def rmsnorm(x, g):
    xf = x.astype(jnp.float32)
    y = xf * lax.rsqrt(jnp.mean(xf * xf, axis=-1, keepdims=True) + EPS)
    return (y * g.astype(jnp.float32)).astype(x.dtype)


def layernorm(x, g, b):
    xf = x.astype(jnp.float32)
    mu = jnp.mean(xf, axis=-1, keepdims=True)
    xc = xf - mu
    y = xc * lax.rsqrt(jnp.mean(xc * xc, axis=-1, keepdims=True) + EPS)
    return (y * g.astype(jnp.float32) + b.astype(jnp.float32)).astype(x.dtype)


def hgrn2_chunkwise(q, k, v, logf, s0):
    B, L = q.shape[0], q.shape[1]
    c = min(A_CHUNK, L)
    n = -(-L // c)
    pad = n * c - L

    def prep(a):
        a = jnp.pad(a.astype(jnp.float32), ((0, 0), (0, pad), (0, 0), (0, 0)))
        return a.reshape(B, n, c, a.shape[2], a.shape[3]).swapaxes(0, 1)

    qc, kc, vc, gc = prep(q), prep(k), prep(v), prep(logf)
    causal = jnp.tril(jnp.ones((c, c), dtype=bool))[None, :, :, None, None]

    def step(S, inp):
        qb, kb, vb, gb = inp
        b = jnp.cumsum(gb, axis=1)
        o_inter = jnp.einsum('bthk,bhkv->bthv', qb * jnp.exp(b), S)
        diff = jnp.where(causal, b[:, :, None] - b[:, None, :], -jnp.inf)
        att = jnp.einsum('bthk,bshk,btshk->btsh', qb, kb, jnp.exp(diff))
        o = o_inter + jnp.einsum('btsh,bshv->bthv', att, vb)
        b_last = b[:, -1]
        k_dec = kb * jnp.exp(b_last[:, None] - b)
        S = jnp.exp(b_last)[..., None] * S + jnp.einsum('bshk,bshv->bhkv', k_dec, vb)
        return S, o

    S, o = lax.scan(step, s0.astype(jnp.float32), (qc, kc, vc, gc))
    o = o.swapaxes(0, 1).reshape(B, n * c, q.shape[2], v.shape[3])[:, :L]
    return o, S


def hgrn2_mixer(h, s0, w_in, lb, g_norm, w_out):
    B, L, _ = h.shape
    proj = h @ w_in
    q, f, i, z = jnp.split(proj, [D_MODEL, 2 * D_MODEL, 2 * D_MODEL + D_INNER], axis=-1)
    q = jax.nn.silu(q).reshape(B, L, A_HEADS, A_DK)
    lbh = lb.astype(jnp.float32).reshape(A_HEADS, A_DK)
    fpre = f.astype(jnp.float32).reshape(B, L, A_HEADS, A_DK)
    logf = jnp.logaddexp(jnp.log(lbh), jnp.log1p(-lbh) + jax.nn.log_sigmoid(fpre))
    k = -jnp.expm1(logf)
    v = i.reshape(B, L, A_HEADS, A_DV)
    o, S = hgrn2_chunkwise(q, k, v, logf, s0)
    o = rmsnorm(o, g_norm).reshape(B, L, D_INNER).astype(h.dtype)
    return (o * jax.nn.silu(z)) @ w_out, S


def chunk_mlp_mixer(h, w_in, ln_g, ln_b, w_sp, b_sp, w_out):
    B, L, _ = h.shape
    proj = h @ w_in
    u, v, z = jnp.split(proj, 3, axis=-1)
    u = jax.nn.gelu(u)
    v = layernorm(jax.nn.gelu(v), ln_g, ln_b)
    c = B_CHUNK
    n = -(-L // c)
    pad = n * c - L
    vc = jnp.pad(v, ((0, 0), (0, pad), (0, 0))).reshape(B, n, c, B_GROUPS, B_DG)
    w = jnp.where(jnp.tril(jnp.ones((c, c), dtype=bool))[None], w_sp, 0.0)
    s = jnp.einsum('gts,bnsgd->bntgd', w, vc) + b_sp.T[None, None, :, :, None]
    s = s.reshape(B, n * c, D_INNER)[:, :L]
    y = (u * s * jax.nn.silu(z)) @ w_out
    v_tail = v[:, ((L - 1) // c) * c:]
    return y, v_tail


def trunk(x, p, s_hgrn, lbs, norm_mix, w_in_a, gnorm_a, w_out_a, w_in_b, ln_v_g, ln_v_b,
          w_spatial, b_spatial, w_out_b, norm_ple, w_ple_gate, w_ple_proj, norm_final):
    h = x
    new_s, new_v = [], []
    for i in range(DEPTH):
        j = i // N_MIXERS
        hn = rmsnorm(h, norm_mix[i])
        if i % N_MIXERS == 0:
            y, S = hgrn2_mixer(hn, s_hgrn[j], w_in_a[j], lbs[j], gnorm_a[j], w_out_a[j])
            new_s.append(S)
        else:
            y, vt = chunk_mlp_mixer(hn, w_in_b[j], ln_v_g[j], ln_v_b[j], w_spatial[j], b_spatial[j], w_out_b[j])
            new_v.append(vt)
        h = h + y
        gate = jax.nn.sigmoid(rmsnorm(h, norm_ple[i]) @ w_ple_gate[i])
        h = h + gate * (p[i] @ w_ple_proj[i])
    return rmsnorm(h, norm_final), jnp.stack(new_s), jnp.stack(new_v)


def setup_inputs(seed: int = 0) -> dict:
    key = jax.random.key(seed)
    ks = jax.random.split(key, 24)
    nrm = jax.random.normal
    f32 = jnp.float32
    return {
        "x_prompt": nrm(ks[0], (BATCH, SEQ, D_MODEL), f32),
        "x_sample": nrm(ks[1], (DEC_BATCH, DEC_SEQ, D_MODEL), f32),
        "state_hgrn": nrm(ks[2], (N_A, DEC_BATCH, A_HEADS, A_DK, A_DV), f32),
        "p_prompt": nrm(ks[3], (DEPTH, BATCH, SEQ, PLE_DIM), f32),
        "p_sample": nrm(ks[4], (DEPTH, DEC_BATCH, DEC_SEQ, PLE_DIM), f32),
        "norm_mix": 1.0 + 0.05 * nrm(ks[5], (DEPTH, D_MODEL), f32),
        "w_in_a": nrm(ks[6], (N_A, D_MODEL, 3 * D_INNER), f32) * D_MODEL ** -0.5,
        "lb_logits": nrm(ks[7], (N_A, A_HEADS * A_DK), f32),
        "gnorm_a": 1.0 + 0.05 * nrm(ks[8], (N_A, A_DV), f32),
        "w_out_a": nrm(ks[9], (N_A, D_INNER, D_MODEL), f32) * D_INNER ** -0.5,
        "w_in_b": nrm(ks[10], (N_B, D_MODEL, 3 * D_INNER), f32) * D_MODEL ** -0.5,
        "ln_v_g": 1.0 + 0.05 * nrm(ks[11], (N_B, D_INNER), f32),
        "ln_v_b": 0.02 * nrm(ks[12], (N_B, D_INNER), f32),
        "w_spatial": nrm(ks[13], (N_B, B_GROUPS, B_CHUNK, B_CHUNK), f32) * B_CHUNK ** -0.5,
        "b_spatial": 1.0 + 0.1 * nrm(ks[14], (N_B, B_GROUPS, B_CHUNK), f32),
        "w_out_b": nrm(ks[15], (N_B, D_INNER, D_MODEL), f32) * D_INNER ** -0.5,
        "norm_ple": 1.0 + 0.05 * nrm(ks[16], (DEPTH, D_MODEL), f32),
        "w_ple_gate": nrm(ks[17], (DEPTH, D_MODEL, D_MODEL), f32) * D_MODEL ** -0.5,
        "w_ple_proj": nrm(ks[18], (DEPTH, PLE_DIM, D_MODEL), f32) * PLE_DIM ** -0.5,
        "norm_final": 1.0 + 0.05 * nrm(ks[19], (D_MODEL,), f32),
    }


def reference(x_prompt, x_sample, state_hgrn, p_prompt, p_sample, norm_mix, w_in_a, lb_logits,
              gnorm_a, w_out_a, w_in_b, ln_v_g, ln_v_b, w_spatial, b_spatial, w_out_b,
              norm_ple, w_ple_gate, w_ple_proj, norm_final):
    lb_cum = jnp.cumsum(jax.nn.softmax(lb_logits.astype(jnp.float32), axis=0), axis=0)
    lbs = lb_cum - lb_cum[0:1]
    s_zero = jnp.zeros((N_A, x_prompt.shape[0], A_HEADS, A_DK, A_DV), jnp.float32)
    y_prompt, state_hgrn_prompt, chunk_v_prompt = trunk(
        x_prompt, p_prompt, s_zero, lbs, norm_mix, w_in_a, gnorm_a, w_out_a, w_in_b, ln_v_g, ln_v_b,
        w_spatial, b_spatial, w_out_b, norm_ple, w_ple_gate, w_ple_proj, norm_final)
    y_sample, state_hgrn_sample, chunk_v_sample = trunk(
        x_sample, p_sample, state_hgrn, lbs, norm_mix, w_in_a, gnorm_a, w_out_a, w_in_b, ln_v_g, ln_v_b,
        w_spatial, b_spatial, w_out_b, norm_ple, w_ple_gate, w_ple_proj, norm_final)
    return (y_prompt, y_sample, state_hgrn_prompt, state_hgrn_sample, chunk_v_prompt, chunk_v_sample)
```

```cpp
#include <hip/hip_runtime.h>
#include <hip/hip_cooperative_groups.h>
#include <cstdio>
#include <cstdint>
namespace cg = cooperative_groups;

#ifndef N_LAUNCH_MODE
#define N_LAUNCH_MODE 1
#endif

#ifndef REP_SCAN
#define REP_SCAN 1
#endif
#ifndef REP_INPROJ
#define REP_INPROJ 1
#endif
#ifndef REP_NORM
#define REP_NORM 1
#endif
#ifndef REP_SPATIAL
#define REP_SPATIAL 1
#endif
#ifndef REP_SYNC
#define REP_SYNC 1
#endif
#define DI __device__ __forceinline__
#define LAS __attribute__((address_space(3)))
typedef unsigned short bf16_t;
typedef short bf16x8 __attribute__((ext_vector_type(8)));
typedef short s16x4 __attribute__((ext_vector_type(4)));
typedef float f32x4 __attribute__((ext_vector_type(4)));
typedef unsigned u32x4 __attribute__((ext_vector_type(4)));
typedef unsigned u32x2 __attribute__((ext_vector_type(2)));

constexpr int DM = 1024, SEQ = 2048, NB = 8, NSMP = 128, DI_ = 2048, NH = 8, DK = 128, DV = 256, PLE_D = 256;
constexpr int MP = NB * SEQ;
constexpr int MR = MP + NSMP;
constexpr int MPAD = 16640;
constexpr float EPS = 1e-6f;
constexpr int NTHREADS = 512, NWAVES = 8;
constexpr int LDS_BYTES = 147456;

constexpr size_t SZ_WIN = (size_t)6144 * 1024 * 2, SZ_WOUT = (size_t)1024 * 2048 * 2, SZ_WG = (size_t)1024 * 1024 * 2, SZ_WP = (size_t)1024 * 256 * 2;
constexpr size_t WS_WINA = 0;
constexpr size_t WS_WOUTA = WS_WINA + 2 * SZ_WIN;
constexpr size_t WS_WINB = WS_WOUTA + 2 * SZ_WOUT;
constexpr size_t WS_WOUTB = WS_WINB + 2 * SZ_WIN;
constexpr size_t WS_WG = WS_WOUTB + 2 * SZ_WOUT;
constexpr size_t WS_WP = WS_WG + 4 * SZ_WG;
constexpr size_t WS_LB = WS_WP + 4 * SZ_WP;
constexpr size_t WS_H = WS_LB + 8192;
constexpr size_t WS_HB = WS_H + (size_t)MPAD * 1024 * 4;
constexpr size_t WS_PB = WS_HB + (size_t)MPAD * 1024 * 2;
constexpr size_t WS_PLE = WS_PB + (size_t)4 * MPAD * 256 * 2;
constexpr size_t WS_Q = WS_PLE + (size_t)4 * MPAD * 1024 * 2;
constexpr size_t WS_LOGF = WS_Q + (size_t)MPAD * 1024 * 2;
constexpr size_t WS_V = WS_LOGF + (size_t)MPAD * 1024 * 4;
constexpr size_t WS_Z = WS_V + (size_t)MPAD * 2048 * 2;
constexpr size_t WS_U = WS_Z + (size_t)MPAD * 2048 * 2;
constexpr size_t WS_A2 = WS_U + (size_t)MPAD * 2048 * 2;
constexpr size_t WS_SL = WS_A2 + (size_t)MPAD * 2048 * 2;
constexpr size_t WS_DSEG = WS_SL + (size_t)64 * 3 * 128 * 256 * 4;
constexpr size_t WS_CTR = WS_DSEG + (size_t)64 * 3 * 128 * 4;
constexpr size_t WS_HBA = WS_CTR + 16384;
constexpr size_t WS_SSPA = WS_HBA + (size_t)MPAD * 1024 * 2;
constexpr size_t WS_SSPB = WS_SSPA + (size_t)MP * 16 * 4;
constexpr size_t WS_SSSA = WS_SSPB + (size_t)MP * 16 * 4;
constexpr size_t WS_SSSB = WS_SSSA + (size_t)128 * 64 * 4;
constexpr size_t WS_LNST = WS_SSSB + (size_t)128 * 64 * 4;
constexpr size_t WS_END = WS_LNST + (size_t)MP * 64 * 4;

constexpr size_t OUT_Y = 0;
constexpr size_t OUT_SP = (size_t)MR * 1024;
constexpr size_t OUT_SS = OUT_SP + (size_t)2 * 8 * 8 * 128 * 256;
constexpr size_t OUT_CVP = OUT_SS + (size_t)2 * 128 * 8 * 128 * 256;
constexpr size_t OUT_CVS = OUT_CVP + (size_t)2 * 8 * 128 * 2048;
constexpr size_t OUT_END = OUT_CVS + (size_t)2 * 128 * 2048;

typedef __bf16 bf16x2_t __attribute__((ext_vector_type(2)));
typedef float f32x2_t __attribute__((ext_vector_type(2)));
DI unsigned pk_bf16(float lo, float hi) { const bf16x2_t r = __builtin_convertvector((f32x2_t){lo, hi}, bf16x2_t); return __builtin_bit_cast(unsigned, r); }
typedef _Float16 h16x2_t __attribute__((ext_vector_type(2)));
typedef unsigned short f16_t;
DI unsigned pk_f16(float lo, float hi) { const h16x2_t r = __builtin_convertvector((f32x2_t){lo, hi}, h16x2_t); return __builtin_bit_cast(unsigned, r); }
DI float f16_lo(unsigned u) { const h16x2_t r = __builtin_bit_cast(h16x2_t, u); return (float)r[0]; }
DI float f16_hi(unsigned u) { const h16x2_t r = __builtin_bit_cast(h16x2_t, u); return (float)r[1]; }
DI float bf_lo(unsigned u) { return __uint_as_float(u << 16); }
DI float bf_hi(unsigned u) { return __uint_as_float(u & 0xffff0000u); }
DI int lane_id_v() { int l; asm volatile("v_mbcnt_lo_u32_b32 %0, -1, 0\n\tv_mbcnt_hi_u32_b32 %0, -1, %0" : "=v"(l)); return l; }
DI float sigm(float x) { return __builtin_amdgcn_rcpf(1.0f + __expf(-x)); }
DI float silu_f(float x) { return x * sigm(x); }
DI float gelu_f(float x) { const float u = 1.5957691216f * (x + 0.044715f * x * x * x); return x * sigm(u); }
DI float wave_sum(float v) {
#pragma unroll
    for (int o = 1; o < 64; o <<= 1) v += __shfl_xor(v, o);
    return v;
}
template <int ACT> DI float act_f(float x) { if (ACT == 1) return silu_f(x); if (ACT == 2) return gelu_f(x); return x; }
constexpr unsigned TS = 272;
DI unsigned off_b(unsigned row, unsigned ch) { return TS * row + 16u * ch; }
DI unsigned tr_addr16(unsigned lane, unsigned c, unsigned ks, unsigned t) {
    const unsigned g = lane >> 4, q = (lane & 15) >> 2, p = lane & 3;
    return off_b(32 * ks + 8 * g + 4 * t + q, 2 * c + (p >> 1)) + 8 * (p & 1);
}
DI bf16x8 tr_frag(LAS unsigned char* img, unsigned lane, unsigned c, unsigned ks) {
    const s16x4 a = __builtin_amdgcn_ds_read_tr16_b64_v4i16((LAS s16x4*)(img + tr_addr16(lane, c, ks, 0)));
    const s16x4 b = __builtin_amdgcn_ds_read_tr16_b64_v4i16((LAS s16x4*)(img + tr_addr16(lane, c, ks, 1)));
    return (bf16x8){a[0], a[1], a[2], a[3], b[0], b[1], b[2], b[3]};
}
DI f32x4 mfma16(bf16x8 a, bf16x8 b, f32x4 c) { return __builtin_amdgcn_mfma_f32_16x16x32_bf16(a, b, c, 0, 0, 0); }

namespace pg8 {
constexpr int BM = 256, BK = 64, HALF = 128, HTB = HALF * BK * 2, STAGE_BYTES = 8 * HTB, NXCD = 8, WGM = 8;
DI int lds_byte(int r, int c) { const int st = (r >> 4) * 2 + (c >> 5), rr = r & 15, cc = c & 31, ob = rr * 64 + cc * 2; return st * 1024 + (ob ^ (((ob >> 9) & 1) << 5)); }
DI void stage_rc(int b, int& R, int& C) { const int st = b / 1024, sb = b % 1024, swz = sb ^ (((sb >> 9) & 1) << 5); R = (st >> 1) * 16 + swz / 64; C = (st & 1) * 32 + (swz % 64) / 2; }
DI int perm32(int rho) { const int n = rho >> 4, i = rho & 15; return 8 * (i >> 2) + 4 * n + (i & 3); }

struct Unit { int pm, pn, z; };
struct Gemm { const bf16_t* A; const bf16_t* Bt; size_t Az, Bz; };
struct Order {
    int nM, nN, nZ, nwg, G, c;
    DI void init(int M, int N, int Z, int G_, int c_) { nM = M / BM; nN = N / BM; nZ = Z; nwg = nM * nN; G = G_; c = c_; }
    DI bool next(int i, Unit& u) const {
        const long L = (long)i * G + c; if (L >= (long)nwg * nZ) return false;
        u.z = (int)(L / nwg); int wgid = (int)(L % nwg);
        { const int q = nwg / NXCD, r = nwg % NXCD, xcd = wgid % NXCD, off = wgid / NXCD; wgid = (xcd < r ? xcd * (q + 1) : r * (q + 1) + (xcd - r) * q) + off; }
        const int nig = WGM * nN, gid = wgid / nig, fm = gid * WGM, gsz = (nM - fm) < WGM ? (nM - fm) : WGM;
        u.pm = fm + ((wgid % nig) % gsz); u.pn = (wgid % nig) / gsz; return true;
    }
};

DI void load_rs(const float* SSP, int row0, float (&rs)[2][4]) {
#pragma unroll
    for (int ai = 0; ai < 2; ++ai)
#pragma unroll
        for (int m = 0; m < 4; ++m) { const f32x4* p = (const f32x4*)(SSP + (size_t)(row0 + ai * HALF + m * 16) * 16); const f32x4 a = p[0], b = p[1], c = p[2], d = p[3];
            const float t = ((a[0] + a[1]) + (a[2] + a[3])) + ((b[0] + b[1]) + (b[2] + b[3])) + ((c[0] + c[1]) + (c[2] + c[3])) + ((d[0] + d[1]) + (d[2] + d[3]));
            rs[ai][m] = 1.0f / sqrtf(t * (1.0f / 1024.0f) + EPS); }
}
constexpr int RSN_OFF = 131072;
struct RsPre { f32x4 a, b, c, d; };
DI RsPre rs_pre_load(const float* SSP, int pm, int tid) { RsPre r; const f32x4* p = (const f32x4*)(SSP + (size_t)(pm * BM + (tid & 255)) * 16); r.a = p[0]; r.b = p[1]; r.c = p[2]; r.d = p[3]; return r; }
DI void rs_pre_store(LAS unsigned char* lds, const RsPre& r, int slot, int tid) {
    const float t = ((r.a[0] + r.a[1]) + (r.a[2] + r.a[3])) + ((r.b[0] + r.b[1]) + (r.b[2] + r.b[3])) + ((r.c[0] + r.c[1]) + (r.c[2] + r.c[3])) + ((r.d[0] + r.d[1]) + (r.d[2] + r.d[3]));
    if (tid < 256) ((LAS float*)(lds + RSN_OFF))[slot * 256 + tid] = 1.0f / sqrtf(t * (1.0f / 1024.0f) + EPS);
}
DI void load_rs_lds(LAS unsigned char* lds, int slot, int wr, int fr, float (&rs)[2][4]) {
#pragma unroll
    for (int ai = 0; ai < 2; ++ai)
#pragma unroll
        for (int m = 0; m < 4; ++m) rs[ai][m] = ((LAS float*)(lds + RSN_OFF))[slot * 256 + ai * HALF + wr * 64 + m * 16 + fr];
}
template <int ACT> DI void store_bf16_tile(const f32x4 (&acc)[2][2][4][2], bf16_t* dst, int ld, const float (&rs)[2][4], size_t bjs = HALF) {
#pragma unroll
    for (int ai = 0; ai < 2; ++ai)
#pragma unroll
        for (int m = 0; m < 4; ++m) { bf16_t* rp = dst + (size_t)(ai * HALF + m * 16) * ld;
#pragma unroll
            for (int bj = 0; bj < 2; ++bj) { const f32x4 v0 = acc[ai][bj][m][0] * rs[ai][m], v1 = acc[ai][bj][m][1] * rs[ai][m];
                u32x4 w; w.x = pk_bf16(act_f<ACT>(v0[0]), act_f<ACT>(v0[1])); w.y = pk_bf16(act_f<ACT>(v0[2]), act_f<ACT>(v0[3]));
                w.z = pk_bf16(act_f<ACT>(v1[0]), act_f<ACT>(v1[1])); w.w = pk_bf16(act_f<ACT>(v1[2]), act_f<ACT>(v1[3]));
                *(u32x4*)(rp + bj * bjs) = w; } }
}
struct EpiInA {
    static constexpr bool PERM = true;
    static constexpr bool HAS_PRE = true;
    bf16_t* Q; f16_t* LOGF; bf16_t* V; bf16_t* Z; const float* lb; const float* SSP;
    DI void operator()(const f32x4 (&acc)[2][2][4][2], const Unit& u, int wr, int wc, int fr, int fq, LAS unsigned char* lds, int slot) const {
        const int row0 = u.pm * BM + wr * 64 + fr, colt = u.pn * BM, cl = wc * 32 + 8 * fq;
        float rs[2][4]; load_rs_lds(lds, slot, wr, fr, rs);
        const size_t bb = (size_t)(u.pm >> 3) * 8; const int t0 = (u.pm & 7) * BM + wr * 64 + fr;
        if (colt < 1024) store_bf16_tile<1>(acc, Q + ((bb + (colt >> 7)) * SEQ + t0) * 128 + cl, 128, rs, (size_t)SEQ * 128);
        else if (colt < 2048) {
            const int c0 = colt - 1024 + cl;
#pragma unroll
            for (int bj = 0; bj < 2; ++bj)
#pragma unroll
                for (int n = 0; n < 2; ++n) { const f32x4 lbv = *(const f32x4*)(lb + c0 + bj * HALF + 4 * n);
#pragma unroll
                    for (int ai = 0; ai < 2; ++ai)
#pragma unroll
                        for (int m = 0; m < 4; ++m) { const f32x4 x = acc[ai][bj][m][n] * rs[ai][m]; f32x4 o;
#pragma unroll
                            for (int e = 0; e < 4; ++e) { const float f = lbv[e] + (1.0f - lbv[e]) * sigm(x[e]); o[e] = __logf(f); }
                            u32x2 oh; oh.x = pk_f16(o[0], o[1]); oh.y = pk_f16(o[2], o[3]);
                            *(u32x2*)(LOGF + ((bb + ((colt - 1024) >> 7) + bj) * SEQ + t0 + ai * HALF + m * 16) * 128 + cl + 4 * n) = oh; } }
        }
        else if (colt < 4096) store_bf16_tile<0>(acc, V + ((bb + ((colt - 2048) >> 8)) * SEQ + t0) * 256 + cl, 256, rs);
        else store_bf16_tile<1>(acc, Z + ((bb + ((colt - 4096) >> 8)) * SEQ + t0) * 256 + cl, 256, rs);
    }
};
struct EpiInB {
    static constexpr bool PERM = true;
    static constexpr bool HAS_PRE = true;
    bf16_t* UZ; bf16_t* GV; const float* SSP; float* LNST;
    DI void operator()(const f32x4 (&acc)[2][2][4][2], const Unit& u, int wr, int wc, int fr, int fq, LAS unsigned char* lds, int slot_rs) const {
        const int row0 = u.pm * BM + wr * 64 + fr, colt = u.pn * BM, cl = wc * 32 + 8 * fq;
        float rs[2][4]; load_rs_lds(lds, slot_rs, wr, fr, rs);
        if (colt < 4096) {
            bf16_t* dst = UZ + (size_t)row0 * 2048 + ((colt + cl) >> 1);
#pragma unroll
            for (int ai = 0; ai < 2; ++ai)
#pragma unroll
                for (int m = 0; m < 4; ++m) { bf16_t* rp = dst + (size_t)(ai * HALF + m * 16) * 2048;
#pragma unroll
                    for (int bj = 0; bj < 2; ++bj) { const f32x4 v0 = acc[ai][bj][m][0] * rs[ai][m], v1 = acc[ai][bj][m][1] * rs[ai][m];
                        u32x2 w; w.x = pk_bf16(gelu_f(v0[0]) * silu_f(v1[0]), gelu_f(v0[1]) * silu_f(v1[1])); w.y = pk_bf16(gelu_f(v0[2]) * silu_f(v1[2]), gelu_f(v0[3]) * silu_f(v1[3]));
                        *(u32x2*)(rp + bj * (HALF / 2)) = w; } }
        } else {
            bf16_t* dst = GV + (size_t)row0 * 2048 + (colt - 4096) + cl; const int slot = (u.pn - 16) * 4 + wc;
#pragma unroll
            for (int ai = 0; ai < 2; ++ai)
#pragma unroll
                for (int m = 0; m < 4; ++m) { bf16_t* rp = dst + (size_t)(ai * HALF + m * 16) * 2048; float s1 = 0.f, s2 = 0.f;
#pragma unroll
                    for (int bj = 0; bj < 2; ++bj) { f32x4 v0 = acc[ai][bj][m][0] * rs[ai][m], v1 = acc[ai][bj][m][1] * rs[ai][m];
#pragma unroll
                        for (int e = 0; e < 4; ++e) { v0[e] = gelu_f(v0[e]); v1[e] = gelu_f(v1[e]); s1 += v0[e] + v1[e]; s2 += v0[e] * v0[e] + v1[e] * v1[e]; }
                        u32x4 w; w.x = pk_bf16(v0[0], v0[1]); w.y = pk_bf16(v0[2], v0[3]); w.z = pk_bf16(v1[0], v1[1]); w.w = pk_bf16(v1[2], v1[3]);
                        *(u32x4*)(rp + bj * HALF) = w; }
                    s1 += __shfl_xor(s1, 16); s1 += __shfl_xor(s1, 32); s2 += __shfl_xor(s2, 16); s2 += __shfl_xor(s2, 32);
                    if (fq == 0) { float* st = LNST + ((size_t)(row0 + ai * HALF + m * 16) * 32 + slot) * 2; st[0] = s1; st[1] = s2; } }
        }
    }
};
struct EpiPle {
    static constexpr bool PERM = true; static constexpr bool HAS_PRE = false;
    bf16_t* PLE;
    DI void operator()(const f32x4 (&acc)[2][2][4][2], const Unit& u, int wr, int wc, int fr, int fq, LAS unsigned char*, int) const {
        const int row0 = u.pm * BM + wr * 64 + fr, colt = u.pn * BM, cl = wc * 32 + 8 * fq;
        const float rs[2][4] = {{1.f, 1.f, 1.f, 1.f}, {1.f, 1.f, 1.f, 1.f}};
        store_bf16_tile<0>(acc, PLE + (size_t)u.z * MPAD * 1024 + (size_t)row0 * 1024 + colt + cl, 1024, rs);
    }
};
struct EpiRes {
    static constexpr bool PERM = false; static constexpr bool HAS_PRE = false;
    const float* Xin; const bf16_t* HBin; bf16_t* HBo; float* SSPo;
    DI void operator()(const f32x4 (&acc)[2][2][4][2], const Unit& u, int wr, int wc, int fr, int fq, LAS unsigned char*, int) const {
        const int row0 = u.pm * BM + wr * 64 + fr, col0 = u.pn * BM + wc * 32 + 4 * fq;
#pragma unroll
        for (int ai = 0; ai < 2; ++ai)
#pragma unroll
            for (int m = 0; m < 4; ++m) { const int row = row0 + ai * HALF + m * 16; const size_t ro = (size_t)row * 1024 + col0; float ss = 0.f;
#pragma unroll
                for (int bj = 0; bj < 2; ++bj)
#pragma unroll
                    for (int n = 0; n < 2; ++n) { f32x4 h;
                        if (Xin) h = *(const f32x4*)(Xin + ro + bj * HALF + n * 16);
                        else { const u32x2 hb = *(const u32x2*)(HBin + ro + bj * HALF + n * 16); h = (f32x4){bf_lo(hb.x), bf_hi(hb.x), bf_lo(hb.y), bf_hi(hb.y)}; }
                        h += acc[ai][bj][m][n];
                        ss += (h[0] * h[0] + h[1] * h[1]) + (h[2] * h[2] + h[3] * h[3]);
                        u32x2 w; w.x = pk_bf16(h[0], h[1]); w.y = pk_bf16(h[2], h[3]); *(u32x2*)(HBo + ro + bj * HALF + n * 16) = w; }
                ss += __shfl_xor(ss, 16); ss += __shfl_xor(ss, 32);
                if (fq == 0) SSPo[(size_t)row * 16 + u.pn * 4 + wc] = ss;
                if (m & 1) asm volatile("" ::: "memory"); }
    }
};
struct EpiGate {
    static constexpr bool PERM = false; static constexpr bool HAS_PRE = true;
    const bf16_t* HBin; const bf16_t* PLE; const float* SSP; bf16_t* HBo; float* Hout; float* SSPo;
    DI void operator()(const f32x4 (&acc)[2][2][4][2], const Unit& u, int wr, int wc, int fr, int fq, LAS unsigned char* lds, int slot) const {
        const int row0 = u.pm * BM + wr * 64 + fr, col0 = u.pn * BM + wc * 32 + 4 * fq;
        float rs[2][4]; load_rs_lds(lds, slot, wr, fr, rs);
#pragma unroll
        for (int ai = 0; ai < 2; ++ai)
#pragma unroll
            for (int m = 0; m < 4; ++m) { const int row = row0 + ai * HALF + m * 16; const size_t ro = (size_t)row * 1024 + col0; float ss = 0.f;
#pragma unroll
                for (int bj = 0; bj < 2; ++bj)
#pragma unroll
                    for (int n = 0; n < 2; ++n) { const u32x2 hb = *(const u32x2*)(HBin + ro + bj * HALF + n * 16), pl = *(const u32x2*)(PLE + ro + bj * HALF + n * 16);
                        const f32x4 a = acc[ai][bj][m][n] * rs[ai][m]; f32x4 h = (f32x4){bf_lo(hb.x), bf_hi(hb.x), bf_lo(hb.y), bf_hi(hb.y)};
                        h[0] += sigm(a[0]) * bf_lo(pl.x); h[1] += sigm(a[1]) * bf_hi(pl.x); h[2] += sigm(a[2]) * bf_lo(pl.y); h[3] += sigm(a[3]) * bf_hi(pl.y);
                        if (HBo) { ss += (h[0] * h[0] + h[1] * h[1]) + (h[2] * h[2] + h[3] * h[3]);
                            u32x2 w; w.x = pk_bf16(h[0], h[1]); w.y = pk_bf16(h[2], h[3]); *(u32x2*)(HBo + ro + bj * HALF + n * 16) = w; }
                        else *(f32x4*)(Hout + ro + bj * HALF + n * 16) = h; }
                if (HBo) { ss += __shfl_xor(ss, 16); ss += __shfl_xor(ss, 32); if (fq == 0) SSPo[(size_t)row * 16 + u.pn * 4 + wc] = ss; }
                if (m & 1) asm volatile("" ::: "memory"); }
    }
};

template <int K, class Epi>
DI void gemm_phase(LAS unsigned char* lds, const int wid_in, const Gemm g, const Order& S, const Epi& E) {
    int wid = wid_in; asm volatile("" : "+s"(wid));
    const int lane = lane_id_v(), tid = wid * 64 + lane, wr = wid >> 2, wc = wid & 3, fr = lane & 15, fq = lane >> 4;
    constexpr int nt = K / BK;
    unsigned voffA, voffB;
    { int R, C; stage_rc(tid * 16, R, C); const int Rb = Epi::PERM ? ((R & ~31) + perm32(R & 31)) : R;
        voffA = (unsigned)(R * K + C) * 2u; voffB = (unsigned)(Rb * K + C) * 2u; }
    constexpr size_t kstep = (size_t)(BK * 2);
    constexpr size_t hstep = (size_t)HALF * K * 2;
    constexpr size_t tstep = 2 * hstep;
    const unsigned ldsw = (unsigned)wid * 1024u;
    const int aoff = lds_byte(wr * 64 + fr, fq * 8), boff = lds_byte(wc * 32 + fr, fq * 8);
#define PG8_SA(b, h) (((b) * 2 + (h)) * HTB)
#define PG8_SB(b, h) ((4 + (b) * 2 + (h)) * HTB)
#define PG8_STAGE(bufoff, gbase, voff) do { _Pragma("unroll") for (int _i = 0; _i < 2; ++_i) \
        __builtin_amdgcn_global_load_lds((const unsigned*)((const char*)(gbase) + (size_t)_i * (64 * K * 2) + (voff)), (LAS unsigned*)(lds + (bufoff) + ldsw + _i * 8192), 16, 0, 0); } while (0)
#define PG8_LDA(dst, b, h) do { _Pragma("unroll") for (int m = 0; m < 4; ++m) _Pragma("unroll") for (int k = 0; k < 2; ++k) dst[m][k] = *(const LAS bf16x8*)(lds + PG8_SA(b, h) + aoff + m * 2048 + k * 1024); } while (0)
#define PG8_LDB(dst, b, h) do { _Pragma("unroll") for (int n = 0; n < 2; ++n) _Pragma("unroll") for (int k = 0; k < 2; ++k) dst[n][k] = *(const LAS bf16x8*)(lds + PG8_SB(b, h) + boff + n * 2048 + k * 1024); } while (0)
#define PG8_MMA(ai, bj, At, Bt) do { __builtin_amdgcn_s_setprio(1); _Pragma("unroll") for (int m = 0; m < 4; ++m) _Pragma("unroll") for (int n = 0; n < 2; ++n) _Pragma("unroll") for (int k = 0; k < 2; ++k) \
        acc[ai][bj][m][n] = __builtin_amdgcn_mfma_f32_16x16x32_bf16(Bt[n][k], At[m][k], acc[ai][bj][m][n], 0, 0, 0); __builtin_amdgcn_s_setprio(0); } while (0)
#define PG8_WAIT_V(n) asm volatile("s_waitcnt vmcnt(" #n ")" ::: "memory")
#define PG8_WAIT_L(n) asm volatile("s_waitcnt lgkmcnt(" #n ")" ::: "memory")
#define PG8_BAR __builtin_amdgcn_s_barrier()
#define PG8_SCHED __builtin_amdgcn_sched_barrier(0)
    Unit cur, nxt; int ui = 0;
    if (!S.next(0, cur)) return;
    f32x4 acc[2][2][4][2];
#pragma unroll
    for (int a = 0; a < 2; ++a)
#pragma unroll
        for (int b = 0; b < 2; ++b)
#pragma unroll
            for (int m = 0; m < 4; ++m)
#pragma unroll
                for (int n = 0; n < 2; ++n) acc[a][b][m][n] = (f32x4){0.f, 0.f, 0.f, 0.f};
    bf16x8 At[4][2], B0[2][2], B1[2][2];
    const char* cA = (const char*)g.A + (size_t)cur.z * g.Az + (size_t)cur.pm * tstep; const char* cB = (const char*)g.Bt + (size_t)cur.z * g.Bz + (size_t)cur.pn * tstep;
    if constexpr (Epi::HAS_PRE) { const RsPre pf = rs_pre_load(E.SSP, cur.pm, tid); rs_pre_store(lds, pf, 0, tid); }
    PG8_STAGE(PG8_SB(0, 0), cB, voffB); PG8_STAGE(PG8_SB(0, 1), cB + hstep, voffB); PG8_STAGE(PG8_SA(0, 0), cA, voffA); PG8_STAGE(PG8_SA(0, 1), cA + hstep, voffA);
    if (wr == 1) PG8_BAR;
    PG8_WAIT_V(2); PG8_BAR;
    PG8_STAGE(PG8_SB(1, 0), cB + kstep, voffB); PG8_STAGE(PG8_SA(1, 0), cA + kstep, voffA); PG8_STAGE(PG8_SB(1, 1), cB + hstep + kstep, voffB);
    PG8_WAIT_V(6); PG8_BAR;
    for (;;) {
        const bool has_next = S.next(ui + 1, nxt);
        const char* nA = has_next ? (const char*)g.A + (size_t)nxt.z * g.Az + (size_t)nxt.pm * tstep : cA; const char* nB = has_next ? (const char*)g.Bt + (size_t)nxt.z * g.Bz + (size_t)nxt.pn * tstep : cB;
#pragma unroll 1
        for (int t = 0; t < nt; t += 2) {
            const bool last = (t == nt - 2);
            const char* a1 = cA + (size_t)(t + 1) * kstep;
            const char* a2 = last ? nA : cA + (size_t)(t + 2) * kstep; const char* b2 = last ? nB : cB + (size_t)(t + 2) * kstep;
            const char* a3 = a2 + kstep; const char* b3 = b2 + kstep;
            PG8_LDB(B0, 0, 0); PG8_LDB(B1, 0, 1); PG8_SCHED; PG8_LDA(At, 0, 0); PG8_STAGE(PG8_SA(1, 1), a1 + hstep, voffA);
            PG8_WAIT_V(8); PG8_WAIT_L(0); PG8_BAR; PG8_MMA(0, 0, At, B0); PG8_MMA(0, 1, At, B1); PG8_BAR; PG8_SCHED;
            PG8_LDA(At, 0, 1); PG8_STAGE(PG8_SB(0, 0), b2, voffB); PG8_STAGE(PG8_SB(0, 1), b2 + hstep, voffB); PG8_STAGE(PG8_SA(0, 0), a2, voffA);
            PG8_WAIT_V(8); PG8_WAIT_L(0); PG8_BAR; PG8_MMA(1, 0, At, B0); PG8_MMA(1, 1, At, B1); PG8_BAR; PG8_SCHED;
            PG8_LDB(B0, 1, 0); PG8_LDB(B1, 1, 1); PG8_SCHED; PG8_LDA(At, 1, 0); PG8_STAGE(PG8_SA(0, 1), a2 + hstep, voffA);
            PG8_WAIT_V(8); PG8_WAIT_L(0); PG8_BAR; PG8_MMA(0, 0, At, B0); PG8_MMA(0, 1, At, B1); PG8_BAR; PG8_SCHED;
            PG8_LDA(At, 1, 1); PG8_STAGE(PG8_SB(1, 0), b3, voffB); PG8_STAGE(PG8_SB(1, 1), b3 + hstep, voffB); PG8_STAGE(PG8_SA(1, 0), a3, voffA);
            PG8_WAIT_V(8); PG8_WAIT_L(0); PG8_BAR; PG8_MMA(1, 0, At, B0); PG8_MMA(1, 1, At, B1); PG8_BAR; PG8_SCHED;
        }
        if (wr == 0) PG8_BAR;
        if constexpr (Epi::HAS_PRE) {
            RsPre pf; if (has_next) pf = rs_pre_load(E.SSP, nxt.pm, tid);
            E(acc, cur, wr, wc, fr, fq, lds, ui & 1);
            if (has_next) rs_pre_store(lds, pf, (ui + 1) & 1, tid);
        } else E(acc, cur, wr, wc, fr, fq, lds, 0);
        if (!has_next) break;
#pragma unroll
        for (int a = 0; a < 2; ++a)
#pragma unroll
            for (int b = 0; b < 2; ++b)
#pragma unroll
                for (int m = 0; m < 4; ++m)
#pragma unroll
                    for (int n = 0; n < 2; ++n) acc[a][b][m][n] = (f32x4){0.f, 0.f, 0.f, 0.f};
        cur = nxt; cA = nA; cB = nB; ++ui;
        if (wr == 1) PG8_BAR;
    }
    PG8_WAIT_V(0);
    PG8_BAR;
#undef PG8_SA
#undef PG8_SB
#undef PG8_STAGE
#undef PG8_LDA
#undef PG8_LDB
#undef PG8_MMA
#undef PG8_WAIT_V
#undef PG8_WAIT_L
#undef PG8_BAR
#undef PG8_SCHED
}
}


DI float thin_rs(const float* SSS, int row) {
    const f32x4* p = (const f32x4*)(SSS + (size_t)(row - MP) * 64); f32x4 t = p[0];
#pragma unroll
    for (int i = 1; i < 16; ++i) t += p[i];
    return 1.0f / sqrtf(((t[0] + t[1]) + (t[2] + t[3])) * (1.0f / 1024.0f) + EPS);
}
struct TEpiInA { bf16_t* Q; f16_t* LOGF; bf16_t* V; bf16_t* Z; const float* lb; const float* SSS;
    DI float rs_of(int row) const { return thin_rs(SSS, row); }
    DI void operator()(int z, int row, int col, f32x4 v, int lane, float rs) const {
        v *= rs;
        if (col < 1024) { u32x2 o; o.x = pk_bf16(silu_f(v[0]), silu_f(v[1])); o.y = pk_bf16(silu_f(v[2]), silu_f(v[3])); *(u32x2*)(Q + (size_t)row * 1024 + col) = o; }
        else if (col < 2048) { const f32x4 lbv = *(const f32x4*)(lb + col - 1024); f32x4 o;
#pragma unroll
            for (int e = 0; e < 4; ++e) o[e] = __logf(lbv[e] + (1.0f - lbv[e]) * sigm(v[e]));
            u32x2 oh; oh.x = pk_f16(o[0], o[1]); oh.y = pk_f16(o[2], o[3]); *(u32x2*)(LOGF + (size_t)row * 1024 + col - 1024) = oh; }
        else if (col < 4096) { u32x2 o; o.x = pk_bf16(v[0], v[1]); o.y = pk_bf16(v[2], v[3]); *(u32x2*)(V + (size_t)row * 2048 + col - 2048) = o; }
        else { u32x2 o; o.x = pk_bf16(silu_f(v[0]), silu_f(v[1])); o.y = pk_bf16(silu_f(v[2]), silu_f(v[3])); *(u32x2*)(Z + (size_t)row * 2048 + col - 4096) = o; }
    } };
struct TEpiInB { bf16_t* UZ; bf16_t* GV; const float* SSS;
    DI float rs_of(int row) const { return thin_rs(SSS, row); }
    DI void operator()(int z, int row, int col, f32x4 v, int lane, float rs) const {
        v *= rs;
        const bool isz = (col & 4) != 0; f32x4 mine, other;
#pragma unroll
        for (int e = 0; e < 4; ++e) { mine[e] = (col < 4096 && isz) ? silu_f(v[e]) : gelu_f(v[e]); other[e] = __shfl_xor(mine[e], 1); }
        if (col < 4096) { if (!isz) { u32x2 o; o.x = pk_bf16(mine[0] * other[0], mine[1] * other[1]); o.y = pk_bf16(mine[2] * other[2], mine[3] * other[3]); *(u32x2*)(UZ + (size_t)row * 2048 + 4 * (col >> 3)) = o; } }
        else { u32x2 o; o.x = pk_bf16(mine[0], mine[1]); o.y = pk_bf16(mine[2], mine[3]); *(u32x2*)(GV + (size_t)row * 2048 + col - 4096) = o; }
    } };
struct TEpiPle { bf16_t* PLE;
    DI float rs_of(int row) const { return 1.0f; }
    DI void operator()(int z, int row, int col, f32x4 v, int lane, float rs) const { u32x2 o; o.x = pk_bf16(v[0], v[1]); o.y = pk_bf16(v[2], v[3]); *(u32x2*)(PLE + (size_t)z * MPAD * 1024 + (size_t)row * 1024 + col) = o; } };
struct TEpiRes { const float* Xin; const bf16_t* HBin; bf16_t* HBo; float* SSSo;
    DI float rs_of(int row) const { return 1.0f; }
    DI void operator()(int z, int row, int col, f32x4 v, int lane, float rs) const { f32x4 h;
        if (Xin) h = *(const f32x4*)(Xin + (size_t)row * 1024 + col);
        else { const u32x2 hb = *(const u32x2*)(HBin + (size_t)row * 1024 + col); h = (f32x4){bf_lo(hb.x), bf_hi(hb.x), bf_lo(hb.y), bf_hi(hb.y)}; }
        h += v;
        float ss = (h[0] * h[0] + h[1] * h[1]) + (h[2] * h[2] + h[3] * h[3]); ss += __shfl_xor(ss, 1); ss += __shfl_xor(ss, 2);
        if ((lane & 3) == 0) SSSo[(size_t)(row - MP) * 64 + (col >> 4)] = ss;
        u32x2 w; w.x = pk_bf16(h[0], h[1]); w.y = pk_bf16(h[2], h[3]); *(u32x2*)(HBo + (size_t)row * 1024 + col) = w; } };
struct TEpiGate { const bf16_t* HBin; const bf16_t* PLE; const float* SSSi; bf16_t* HBo; float* Hout; float* SSSo;
    DI float rs_of(int row) const { return thin_rs(SSSi, row); }
    DI void operator()(int z, int row, int col, f32x4 v, int lane, float rs) const {
        const u32x2 hb = *(const u32x2*)(HBin + (size_t)row * 1024 + col), pl = *(const u32x2*)(PLE + (size_t)row * 1024 + col);
        f32x4 h = (f32x4){bf_lo(hb.x), bf_hi(hb.x), bf_lo(hb.y), bf_hi(hb.y)};
        v *= rs;
        h[0] += sigm(v[0]) * bf_lo(pl.x); h[1] += sigm(v[1]) * bf_hi(pl.x); h[2] += sigm(v[2]) * bf_lo(pl.y); h[3] += sigm(v[3]) * bf_hi(pl.y);
        if (HBo) { float ss = (h[0] * h[0] + h[1] * h[1]) + (h[2] * h[2] + h[3] * h[3]); ss += __shfl_xor(ss, 1); ss += __shfl_xor(ss, 2);
            if ((lane & 3) == 0) SSSo[(size_t)(row - MP) * 64 + (col >> 4)] = ss;
            u32x2 w; w.x = pk_bf16(h[0], h[1]); w.y = pk_bf16(h[2], h[3]); *(u32x2*)(HBo + (size_t)row * 1024 + col) = w; }
        else *(f32x4*)(Hout + (size_t)row * 1024 + col) = h; } };

template <int K, int NPB, int MT, class Epi>
DI void thin_gemm(LAS unsigned char* lds, const int w, const bf16_t* A  , size_t Az  , const bf16_t* Bt, size_t Bz, const int N, const int nZ,
                  const int bid, const int G, const Epi& E) {
    const int lane = lane_id_v(), tid = w * 64 + lane, fr = lane & 15, fq = lane >> 4;
    constexpr int KW = K / 8, KS = KW / 32;
    constexpr int NMB = 8 / MT;
    LAS float* P = (LAS float*)lds;
    const int npn = N / 16;
    const int ei = tid >> 6, ee = (tid & 63) * 4, er = ee >> 4, ec = ee & 15;
    float rs_row = 1.0f; if (MT == 8) rs_row = E.rs_of(MP + 16 * ei + er);
    for (int p = bid * NPB; p < npn * nZ * NMB; p += G * NPB) {
        const int mblk = p % NMB, pc = p / NMB, z = pc / npn, ng = pc % npn;
        const int mrow = 16 * MT * mblk;
        const bf16_t* a0 = A + (size_t)z * Az + (size_t)(mrow + fr) * K + w * KW + 8 * fq;
        const bf16_t* b0 = Bt + (size_t)z * Bz + (size_t)(16 * ng + fr) * K + w * KW + 8 * fq;
        f32x4 acc[NPB][MT];
#pragma unroll
        for (int q = 0; q < NPB; ++q)
#pragma unroll
            for (int i = 0; i < MT; ++i) acc[q][i] = (f32x4){0.f, 0.f, 0.f, 0.f};
        constexpr int KBM = (NPB > 1 ? 2 : 4) * (8 / MT), KB = KS < KBM ? KS : KBM;
#pragma unroll
        for (int kb = 0; kb < KS; kb += KB) {
            bf16x8 bfr[NPB][KB], afr[KB][MT];
#pragma unroll
            for (int kk = 0; kk < KB; ++kk) {
#pragma unroll
                for (int q = 0; q < NPB; ++q) bfr[q][kk] = *(const bf16x8*)(b0 + (size_t)(16 * q) * K + 32 * (kb + kk));
#pragma unroll
                for (int i = 0; i < MT; ++i) afr[kk][i] = *(const bf16x8*)(a0 + (size_t)(16 * i) * K + 32 * (kb + kk)); }
#pragma unroll
            for (int kk = 0; kk < KB; ++kk)
#pragma unroll
                for (int i = 0; i < MT; ++i)
#pragma unroll
                    for (int q = 0; q < NPB; ++q) acc[q][i] = mfma16(afr[kk][i], bfr[q][kk], acc[q][i]);
        }
        if (MT < 8 && ei < MT) rs_row = E.rs_of(MP + mrow + 16 * ei + er);
#pragma unroll
        for (int q = 0; q < NPB; ++q) {
#pragma unroll
            for (int i = 0; i < MT; ++i)
#pragma unroll
                for (int jj = 0; jj < 4; ++jj) P[(w * MT + i) * 256 + (4 * fq + jj) * 16 + fr] = acc[q][i][jj];
            __syncthreads();
            if (MT == 8 || ei < MT) {
                f32x4 v = (f32x4){0.f, 0.f, 0.f, 0.f};
#pragma unroll
                for (int ww = 0; ww < 8; ++ww) v += *(LAS f32x4*)(P + (ww * MT + ei) * 256 + ee);
                E(z, MP + mrow + 16 * ei + er, 16 * (ng + q) + ec, v, lane, rs_row);
            }
            __syncthreads();
        }
    }
}

DI int uz_row(int n) { return n < 2048 ? 8 * (n >> 2) + (n & 3) : (n < 4096 ? n + 2048 : 8 * ((n - 4096) >> 2) + 4 + (n & 3)); }
template <bool UZMAP = false>
DI void transpose_item(const float* W, int K, int N, bf16_t* WT, LAS float* scr, int item, int lane, const float* kscale = nullptr) {
    const int nblk = N / 32, kb = item / nblk, nb = item % nblk, k0 = 64 * kb, n0 = 32 * nb;
#pragma unroll
    for (int i = 0; i < 8; ++i) { const int kk = 8 * i + (lane >> 3), n4 = (lane & 7) * 4;
        const f32x4 v = *(const f32x4*)(W + (size_t)(k0 + kk) * N + n0 + n4); const float sc = kscale ? kscale[k0 + kk] : 1.0f;
        scr[kk * 33 + n4 + 0] = v[0] * sc; scr[kk * 33 + n4 + 1] = v[1] * sc; scr[kk * 33 + n4 + 2] = v[2] * sc; scr[kk * 33 + n4 + 3] = v[3] * sc; }
    asm volatile("s_waitcnt lgkmcnt(0)" ::: "memory");
    const int c = lane & 7;
#pragma unroll
    for (int j = 0; j < 4; ++j) { const int n = (lane >> 3) + 8 * j; const LAS float* s = scr + (8 * c) * 33 + n;
        u32x4 o; o.x = pk_bf16(s[0 * 33], s[1 * 33]); o.y = pk_bf16(s[2 * 33], s[3 * 33]); o.z = pk_bf16(s[4 * 33], s[5 * 33]); o.w = pk_bf16(s[6 * 33], s[7 * 33]);
        *(u32x4*)(WT + (size_t)(UZMAP ? uz_row(n0 + n) : n0 + n) * K + k0 + 8 * c) = o; }
    asm volatile("s_waitcnt lgkmcnt(0)" ::: "memory");
}

struct TDesc { const float* W; bf16_t* WT; const float* ks; int K, N, item; bool uz; };
DI void t_load(const TDesc& d, int lane, f32x4 (&v)[8], float (&sc)[8]) {
    const int nblk = d.N / 32, kb = d.item / nblk, nb = d.item % nblk, k0 = 64 * kb, n0 = 32 * nb;
#pragma unroll
    for (int i = 0; i < 8; ++i) { const int kk = 8 * i + (lane >> 3), n4 = (lane & 7) * 4;
        v[i] = *(const f32x4*)(d.W + (size_t)(k0 + kk) * d.N + n0 + n4); sc[i] = d.ks ? d.ks[k0 + kk] : 1.0f; }
}
DI void t_store(const TDesc& d, LAS float* scr, int lane, const f32x4 (&v)[8], const float (&sc)[8]) {
    const int nblk = d.N / 32, kb = d.item / nblk, nb = d.item % nblk, k0 = 64 * kb, n0 = 32 * nb;
#pragma unroll
    for (int i = 0; i < 8; ++i) { const int kk = 8 * i + (lane >> 3), n4 = (lane & 7) * 4;
        scr[kk * 33 + n4 + 0] = v[i][0] * sc[i]; scr[kk * 33 + n4 + 1] = v[i][1] * sc[i]; scr[kk * 33 + n4 + 2] = v[i][2] * sc[i]; scr[kk * 33 + n4 + 3] = v[i][3] * sc[i]; }
    asm volatile("s_waitcnt lgkmcnt(0)" ::: "memory");
    const int c = lane & 7;
#pragma unroll
    for (int j = 0; j < 4; ++j) { const int n = (lane >> 3) + 8 * j; const LAS float* sp = scr + (8 * c) * 33 + n;
        u32x4 o; o.x = pk_bf16(sp[0 * 33], sp[1 * 33]); o.y = pk_bf16(sp[2 * 33], sp[3 * 33]); o.z = pk_bf16(sp[4 * 33], sp[5 * 33]); o.w = pk_bf16(sp[6 * 33], sp[7 * 33]);
        *(u32x4*)(d.WT + (size_t)(d.uz ? uz_row(n0 + n) : n0 + n) * d.K + k0 + 8 * c) = o; }
    asm volatile("s_waitcnt lgkmcnt(0)" ::: "memory");
}

DI void rms_row(const float* src, const float* g, bf16_t* dstb, float* hcopy, float* outf, int lane) {
    f32x4 v[4]; float s = 0.f;
#pragma unroll
    for (int j = 0; j < 4; ++j) { v[j] = src ? ((const f32x4*)src)[lane + 64 * j] : (f32x4){0.f, 0.f, 0.f, 0.f}; s += (v[j][0] * v[j][0] + v[j][1] * v[j][1]) + (v[j][2] * v[j][2] + v[j][3] * v[j][3]); }
    const float rs = 1.0f / sqrtf(wave_sum(s) * (1.0f / 1024.0f) + EPS);
#pragma unroll
    for (int j = 0; j < 4; ++j) { const f32x4 gv = ((const f32x4*)g)[lane + 64 * j]; const f32x4 y = v[j] * rs * gv;
        if (hcopy) ((f32x4*)hcopy)[lane + 64 * j] = v[j];
        if (outf) ((f32x4*)outf)[lane + 64 * j] = y;
        if (dstb) { u32x2 w; w.x = pk_bf16(y[0], y[1]); w.y = pk_bf16(y[2], y[3]); ((u32x2*)dstb)[lane + 64 * j] = w; } }
}

constexpr int SC_QD = 0, SC_KD = 17408, SC_VI = 34816, SC_ATT = 69632, SC_BB = 78848, SC_ER = 112640, SC_EL = 113152, SC_RR = 113664, SC_TOT = 114176, SC_DS = 116224, SC_MISC = 116736;
constexpr int ATT_STRIDE = 144, OT_STRIDE = 528, VIMG = 17408, BBS = 132;
constexpr int NSEG = 4, CPS = (SEQ / 64) / NSEG;

DI bf16x8 tr_frag2(LAS unsigned char* p) {
    const s16x4 a = __builtin_amdgcn_ds_read_tr16_b64_v4i16((LAS s16x4*)p);
    const s16x4 b = __builtin_amdgcn_ds_read_tr16_b64_v4i16((LAS s16x4*)(p + 4 * TS));
    return (bf16x8){a[0], a[1], a[2], a[3], b[0], b[1], b[2], b[3]};
}

template <int MODE>
DI void scan_prompt(LAS unsigned char* lds, const int w, const int bh, const int seg, const bf16_t* Q, const f16_t* LOGF, const bf16_t* V, const bf16_t* Z, bf16_t* A2, const float* gn, float* Sout,
                    float* SL, float* DSEG) {
    const int lane = lane_id_v(), tid = w * 64 + lane, fr = lane & 15, fq = lane >> 4;
    const int b = bh >> 3, h = bh & 7;
    const int lt = tid >> 3, lg = tid & 7;
    const size_t row_base = (size_t)b * SEQ + (size_t)seg * CPS * 64;
    const size_t hm_base = (size_t)bh * SEQ + (size_t)seg * CPS * 64;
    LAS float* BB = (LAS float*)(lds + SC_BB); LAS float* ER = (LAS float*)(lds + SC_ER); LAS float* EL = (LAS float*)(lds + SC_EL); LAS float* RR = (LAS float*)(lds + SC_RR);
    LAS float* TOT = (LAS float*)(lds + SC_TOT); LAS float* DS = (LAS float*)(lds + SC_DS);
    LAS unsigned char* rb16 = lds + fr * TS + fq * 16;
    LAS unsigned char* rb8 = lds + fr * TS + fq * 8;
    LAS unsigned char* trb = lds + (8 * fq + ((lane & 15) >> 2)) * TS + (lane & 3) * 8;
    LAS unsigned char* atb = lds + SC_ATT + fr * ATT_STRIDE + fq * 16;
    f32x4 Sacc[8][2];
#pragma unroll
    for (int mb = 0; mb < 8; ++mb) { Sacc[mb][0] = (f32x4){0.f, 0.f, 0.f, 0.f}; Sacc[mb][1] = (f32x4){0.f, 0.f, 0.f, 0.f}; }
    if (MODE == 0) {
        f32x4 coef[8];
#pragma unroll
        for (int mb = 0; mb < 8; ++mb) coef[mb] = (f32x4){1.f, 1.f, 1.f, 1.f};
        for (int sp = seg - 1; sp >= 0; --sp) {
            const float* sl = SL + ((size_t)bh * (NSEG - 1) + sp) * 128 * 256 + tid;
            float t[64];
#pragma unroll
            for (int idx = 0; idx < 64; ++idx) t[idx] = __builtin_nontemporal_load(sl + (size_t)idx * 512);
#pragma unroll
            for (int mb = 0; mb < 8; ++mb)
#pragma unroll
                for (int nt = 0; nt < 2; ++nt)
#pragma unroll
                    for (int jj = 0; jj < 4; ++jj) Sacc[mb][nt][jj] += coef[mb][jj] * t[(mb * 2 + nt) * 4 + jj];
            if (sp > 0) { const float* dd = DSEG + ((size_t)bh * (NSEG - 1) + sp) * 128;
#pragma unroll
                for (int mb = 0; mb < 8; ++mb) { f32x4 e4 = *(const f32x4*)(dd + 16 * mb + 4 * fq);
                    e4[0] = __expf(e4[0]); e4[1] = __expf(e4[1]); e4[2] = __expf(e4[2]); e4[3] = __expf(e4[3]); coef[mb] *= e4; } }
        }
    } else { if (tid < 128) DS[tid] = 0.f; }
    EL[tid & 127] = 1.0f;
    if (MODE == 0) { if (tid < 256) ((LAS float*)(lds + SC_MISC))[tid] = gn[tid]; }
    u32x4 rq[2]; u32x4 rl[2]; u32x4 rv[4];
    {
        const size_t row = hm_base + lt;
        if (MODE == 0) { const u32x4* qp = (const u32x4*)(Q + row * 128 + 16 * lg); rq[0] = qp[0]; rq[1] = qp[1]; }
        const u32x4* lp = (const u32x4*)(LOGF + row * 128 + 16 * lg);
#pragma unroll
        for (int i = 0; i < 2; ++i) rl[i] = lp[i];
        const u32x4* vp = (const u32x4*)(V + row * 256 + 32 * lg);
#pragma unroll
        for (int i = 0; i < 4; ++i) rv[i] = vp[i];
    }
#pragma unroll 1
    for (int c = 0; c < CPS; ++c) {
        unsigned kkp[8];
#pragma unroll
        for (int i = 0; i < 4; ++i) { const unsigned p0 = rl[i >> 1][2 * (i & 1)], p1 = rl[i >> 1][2 * (i & 1) + 1];
            const f32x4 lf = (f32x4){f16_lo(p0), f16_hi(p0), f16_lo(p1), f16_hi(p1)};
            *(LAS f32x4*)(BB + lt * BBS + 16 * lg + 4 * i) = lf;
            kkp[2 * i] = pk_bf16(1.0f - __expf(lf[0]), 1.0f - __expf(lf[1])); kkp[2 * i + 1] = pk_bf16(1.0f - __expf(lf[2]), 1.0f - __expf(lf[3])); }
#pragma unroll
        for (int i = 0; i < 4; ++i) *(LAS u32x4*)(lds + SC_VI + (lg >> 2) * VIMG + lt * TS + (4 * (lg & 3) + i) * 16) = rv[i];
        __syncthreads();
        {
            const int sg = w >> 1, k = tid & 127; float run[16]; float s = 0.f;
#pragma unroll
            for (int i = 0; i < 16; ++i) { s += BB[(16 * sg + i) * BBS + k]; run[i] = s; }
            TOT[sg * 128 + k] = s;
            __syncthreads();
            const float t0 = TOT[k], t1 = TOT[128 + k], t2 = TOT[256 + k];
            const float off = (sg > 0 ? t0 : 0.f) + (sg > 1 ? t1 : 0.f) + (sg > 2 ? t2 : 0.f);
#pragma unroll
            for (int i = 0; i < 16; ++i) BB[(16 * sg + i) * BBS + k] = run[i] + off;
            if (sg == 3) { const float r = t0 + t1, bl = off + run[15]; RR[k] = r; ER[k] = EL[k] * __expf(r); EL[k] = __expf(bl - r); if (MODE == 1) DS[k] += bl; }
            __syncthreads();
        }
        {
#pragma unroll
            for (int hh = 0; hh < 2; ++hh) {
                const f32x4 b0 = *(LAS f32x4*)(BB + lt * BBS + 16 * lg + 8 * hh), b1 = *(LAS f32x4*)(BB + lt * BBS + 16 * lg + 8 * hh + 4);
                const f32x4 r0 = *(LAS f32x4*)(RR + 16 * lg + 8 * hh), r1 = *(LAS f32x4*)(RR + 16 * lg + 8 * hh + 4);
                const f32x4 d0 = b0 - r0, d1 = b1 - r1;
                u32x4 ko;
                if (MODE == 0) { u32x4 qo;
                    qo.x = pk_bf16(bf_lo(rq[hh].x) * __expf(d0[0]), bf_hi(rq[hh].x) * __expf(d0[1])); qo.y = pk_bf16(bf_lo(rq[hh].y) * __expf(d0[2]), bf_hi(rq[hh].y) * __expf(d0[3]));
                    qo.z = pk_bf16(bf_lo(rq[hh].z) * __expf(d1[0]), bf_hi(rq[hh].z) * __expf(d1[1])); qo.w = pk_bf16(bf_lo(rq[hh].w) * __expf(d1[2]), bf_hi(rq[hh].w) * __expf(d1[3]));
                    *(LAS u32x4*)(lds + SC_QD + lt * TS + (2 * lg + hh) * 16) = qo; }
                ko.x = pk_bf16(bf_lo(kkp[4 * hh]) * __expf(-d0[0]), bf_hi(kkp[4 * hh]) * __expf(-d0[1])); ko.y = pk_bf16(bf_lo(kkp[4 * hh + 1]) * __expf(-d0[2]), bf_hi(kkp[4 * hh + 1]) * __expf(-d0[3]));
                ko.z = pk_bf16(bf_lo(kkp[4 * hh + 2]) * __expf(-d1[0]), bf_hi(kkp[4 * hh + 2]) * __expf(-d1[1])); ko.w = pk_bf16(bf_lo(kkp[4 * hh + 3]) * __expf(-d1[2]), bf_hi(kkp[4 * hh + 3]) * __expf(-d1[3]));
                *(LAS u32x4*)(lds + SC_KD + lt * TS + (2 * lg + hh) * 16) = ko;
            }
        }
        if (MODE == 1) {
        if (c + 1 < CPS) {
            const size_t row = hm_base + (size_t)(c + 1) * 64 + lt;
            if (MODE == 0) { const u32x4* qp = (const u32x4*)(Q + row * 128 + 16 * lg); rq[0] = qp[0]; rq[1] = qp[1]; }
            const u32x4* lp = (const u32x4*)(LOGF + row * 128 + 16 * lg);
#pragma unroll
            for (int i = 0; i < 2; ++i) rl[i] = lp[i];
            const u32x4* vp = (const u32x4*)(V + row * 256 + 32 * lg);
#pragma unroll
            for (int i = 0; i < 4; ++i) rv[i] = vp[i];
        }
        }
        __syncthreads();
        if (MODE == 0) {
            const int mt = w >> 1;
#pragma unroll
            for (int q2 = 0; q2 < 2; ++q2) {
                const int ntp = 2 * (w & 1) + q2;
                f32x4 a4 = (f32x4){0.f, 0.f, 0.f, 0.f};
                if (ntp <= mt) {
#pragma unroll
                    for (int ks = 0; ks < 4; ++ks) {
                        const bf16x8 a = *(LAS bf16x8*)(rb16 + SC_QD + mt * 16 * TS + ks * 64);
                        const bf16x8 bq = *(LAS bf16x8*)(rb16 + SC_KD + ntp * 16 * TS + ks * 64);
                        a4 = mfma16(a, bq, a4);
                    }
                }
#pragma unroll
                for (int jj = 0; jj < 4; ++jj) { const int t = 16 * mt + 4 * fq + jj, s = 16 * ntp + fr; const float val = (s <= t) ? a4[jj] : 0.f;
                    *(LAS bf16_t*)(lds + SC_ATT + t * ATT_STRIDE + s * 2) = (bf16_t)(pk_bf16(val, 0.f) & 0xffffu); }
            }
        }
#pragma unroll
        for (int mb = 0; mb < 8; ++mb) { const f32x4 e4 = *(LAS f32x4*)(ER + 16 * mb + 4 * fq); Sacc[mb][0] *= e4; Sacc[mb][1] *= e4; }
        u32x4 zr[4];
        if (MODE == 0) {
            const u32x4* zp = (const u32x4*)(Z + (hm_base + (size_t)c * 64 + lt) * 256 + 32 * lg);
#pragma unroll
            for (int i = 0; i < 4; ++i) zr[i] = zp[i];
            __syncthreads();
        }
        {
            bf16x8 Vf[2][2];
            LAS unsigned char* vtr = trb + SC_VI + (w >> 2) * VIMG + (w & 3) * 64;
#pragma unroll
            for (int ks = 0; ks < 2; ++ks)
#pragma unroll
                for (int nt = 0; nt < 2; ++nt) Vf[ks][nt] = tr_frag2(vtr + ks * 32 * TS + nt * 32);
            if (MODE == 0) {
                f32x4 Oacc[4][2];
#pragma unroll
                for (int mt = 0; mt < 4; ++mt) { Oacc[mt][0] = (f32x4){0.f, 0.f, 0.f, 0.f}; Oacc[mt][1] = (f32x4){0.f, 0.f, 0.f, 0.f}; }
#pragma unroll
                for (int kb = 0; kb < 4; ++kb) {
                    bf16x8 Bf[2];
#pragma unroll
                    for (int nt = 0; nt < 2; ++nt) { u32x4 p; p.x = pk_bf16(Sacc[2 * kb][nt][0], Sacc[2 * kb][nt][1]); p.y = pk_bf16(Sacc[2 * kb][nt][2], Sacc[2 * kb][nt][3]);
                        p.z = pk_bf16(Sacc[2 * kb + 1][nt][0], Sacc[2 * kb + 1][nt][1]); p.w = pk_bf16(Sacc[2 * kb + 1][nt][2], Sacc[2 * kb + 1][nt][3]); Bf[nt] = __builtin_bit_cast(bf16x8, p); }
#pragma unroll
                    for (int mt = 0; mt < 4; ++mt) {
                        const u32x2 lo = *(LAS u32x2*)(rb8 + SC_QD + mt * 16 * TS + kb * 64);
                        const u32x2 hi = *(LAS u32x2*)(rb8 + SC_QD + mt * 16 * TS + kb * 64 + 32);
                        const bf16x8 a = __builtin_bit_cast(bf16x8, (u32x4){lo.x, lo.y, hi.x, hi.y});
                        Oacc[mt][0] = mfma16(a, Bf[0], Oacc[mt][0]); Oacc[mt][1] = mfma16(a, Bf[1], Oacc[mt][1]);
                    }
                }
#pragma unroll
                for (int ks = 0; ks < 2; ++ks)
#pragma unroll
                    for (int mt = 0; mt < 4; ++mt) {
                        const bf16x8 a = *(LAS bf16x8*)(atb + mt * 16 * ATT_STRIDE + ks * 64);
                        Oacc[mt][0] = mfma16(a, Vf[ks][0], Oacc[mt][0]); Oacc[mt][1] = mfma16(a, Vf[ks][1], Oacc[mt][1]);
                    }
                LAS unsigned char* OT = lds + SC_BB;
#pragma unroll
                for (int mt = 0; mt < 4; ++mt)
#pragma unroll
                    for (int jj = 0; jj < 4; ++jj) { const int t = 16 * mt + 4 * fq + jj;
                        *(LAS bf16_t*)(OT + t * OT_STRIDE + (32 * w + fr) * 2) = (bf16_t)(pk_bf16(Oacc[mt][0][jj], 0.f) & 0xffffu);
                        *(LAS bf16_t*)(OT + t * OT_STRIDE + (32 * w + 16 + fr) * 2) = (bf16_t)(pk_bf16(Oacc[mt][1][jj], 0.f) & 0xffffu); }
            }
#pragma unroll
            for (int mb = 0; mb < 8; ++mb)
#pragma unroll
                for (int ks = 0; ks < 2; ++ks) {
                    const bf16x8 a = tr_frag2(trb + SC_KD + ks * 32 * TS + mb * 32);
                    Sacc[mb][0] = mfma16(a, Vf[ks][0], Sacc[mb][0]); Sacc[mb][1] = mfma16(a, Vf[ks][1], Sacc[mb][1]);
                }
        }
        __syncthreads();
        if (MODE == 0) {
            LAS unsigned char* OT = lds + SC_BB; LAS float* GN = (LAS float*)(lds + SC_MISC);
            u32x4 o8[4]; float ssq = 0.f;
#pragma unroll
            for (int i = 0; i < 4; ++i) { o8[i] = *(LAS u32x4*)(OT + lt * OT_STRIDE + (32 * lg + 8 * i) * 2);
#pragma unroll
                for (int e = 0; e < 4; ++e) { const float a = bf_lo(o8[i][e]), c2 = bf_hi(o8[i][e]); ssq += a * a + c2 * c2; } }
            ssq += __shfl_xor(ssq, 1); ssq += __shfl_xor(ssq, 2); ssq += __shfl_xor(ssq, 4);
            const float rs = 1.0f / sqrtf(ssq * (1.0f / 256.0f) + EPS);
            u32x4* op = (u32x4*)(A2 + (row_base + (size_t)c * 64 + lt) * 2048 + 256 * h + 32 * lg);
#pragma unroll
            for (int i = 0; i < 4; ++i) { const f32x4 g0 = *(LAS f32x4*)(GN + 32 * lg + 8 * i), g1 = *(LAS f32x4*)(GN + 32 * lg + 8 * i + 4); u32x4 r;
                r.x = pk_bf16(bf_lo(o8[i].x) * rs * g0[0] * bf_lo(zr[i].x), bf_hi(o8[i].x) * rs * g0[1] * bf_hi(zr[i].x));
                r.y = pk_bf16(bf_lo(o8[i].y) * rs * g0[2] * bf_lo(zr[i].y), bf_hi(o8[i].y) * rs * g0[3] * bf_hi(zr[i].y));
                r.z = pk_bf16(bf_lo(o8[i].z) * rs * g1[0] * bf_lo(zr[i].z), bf_hi(o8[i].z) * rs * g1[1] * bf_hi(zr[i].z));
                r.w = pk_bf16(bf_lo(o8[i].w) * rs * g1[2] * bf_lo(zr[i].w), bf_hi(o8[i].w) * rs * g1[3] * bf_hi(zr[i].w));
                op[i] = r; }
            if (c + 1 < CPS) {
                const size_t row = hm_base + (size_t)(c + 1) * 64 + lt;
                if (MODE == 0) { const u32x4* qp = (const u32x4*)(Q + row * 128 + 16 * lg); rq[0] = qp[0]; rq[1] = qp[1]; }
                const u32x4* lp = (const u32x4*)(LOGF + row * 128 + 16 * lg);
#pragma unroll
                for (int i = 0; i < 2; ++i) rl[i] = lp[i];
                const u32x4* vp = (const u32x4*)(V + row * 256 + 32 * lg);
#pragma unroll
                for (int i = 0; i < 4; ++i) rv[i] = vp[i];
            }
            __syncthreads();
        }
    }
#pragma unroll
    for (int mb = 0; mb < 8; ++mb) { const f32x4 e4 = *(LAS f32x4*)(EL + 16 * mb + 4 * fq); Sacc[mb][0] *= e4; Sacc[mb][1] *= e4; }
    if (MODE == 1) {
        float* sl = SL + ((size_t)bh * (NSEG - 1) + seg) * 128 * 256 + tid;
#pragma unroll
        for (int mb = 0; mb < 8; ++mb)
#pragma unroll
            for (int nt = 0; nt < 2; ++nt)
#pragma unroll
                for (int jj = 0; jj < 4; ++jj) sl[(size_t)((mb * 2 + nt) * 4 + jj) * 512] = Sacc[mb][nt][jj];
        if (tid < 128) DSEG[((size_t)bh * (NSEG - 1) + seg) * 128 + tid] = DS[tid];
        __syncthreads();
    } else if (seg == NSEG - 1) {
        float* so = Sout + (size_t)bh * 128 * 256;
#pragma unroll
        for (int mb = 0; mb < 8; ++mb)
#pragma unroll
            for (int nt = 0; nt < 2; ++nt)
#pragma unroll
                for (int jj = 0; jj < 4; ++jj) so[(size_t)(16 * mb + 4 * fq + jj) * 256 + 32 * w + 16 * nt + fr] = Sacc[mb][nt][jj];
    }
    if (MODE == 0) __syncthreads();
}

DI void scan_sample(LAS unsigned char* lds, const int w, int item, const bf16_t* Q, const f16_t* LOGF, const bf16_t* V, const bf16_t* Z, bf16_t* A2, const float* gn, const float* S0, float* S1) {
    const int lane = lane_id_v(), tid = w * 64 + lane;
    const int b = item >> 3, h = item & 7; const size_t row = (size_t)MP + b;
    LAS float* F = (LAS float*)lds; LAS float* KK = F + 128; LAS float* QQ = F + 256; LAS float* RED = F + 384; LAS float* WS4 = F + 384 + 2048;
    const float* s0 = S0 + (size_t)(b * 8 + h) * 128 * 256; float* s1 = S1 + (size_t)(b * 8 + h) * 128 * 256;
    f32x4 sv[16];
#pragma unroll
    for (int i = 0; i < 16; ++i) sv[i] = __builtin_nontemporal_load((const f32x4*)(s0 + (size_t)(w + 8 * i) * 256) + lane);
    if (tid < 128) { const float lf = (float)__builtin_bit_cast(_Float16, LOGF[row * 1024 + 128 * h + tid]); const float f = __expf(lf); F[tid] = f; KK[tid] = 1.0f - f; QQ[tid] = bf_lo((unsigned)Q[row * 1024 + 128 * h + tid]); }
    const u32x2 vv = *(const u32x2*)(V + row * 2048 + 256 * h + 4 * lane);
    const f32x4 v4 = (f32x4){bf_lo(vv.x), bf_hi(vv.x), bf_lo(vv.y), bf_hi(vv.y)};
    __syncthreads();
    f32x4 o = (f32x4){0.f, 0.f, 0.f, 0.f};
#pragma unroll
    for (int i = 0; i < 16; ++i) { const int k = w + 8 * i; const f32x4 sn = sv[i] * F[k] + v4 * KK[k]; o += sn * QQ[k];
        __builtin_nontemporal_store(sn, (f32x4*)(s1 + (size_t)k * 256) + lane); }
    *(LAS f32x4*)(RED + w * 256 + 4 * lane) = o;
    __syncthreads();
    if (tid < 256) { float s = 0.f;
#pragma unroll
        for (int i = 0; i < 8; ++i) s += RED[i * 256 + tid];
        const float p = wave_sum(s * s); if (lane == 0) WS4[w] = p;
        RED[tid] = s; }
    __syncthreads();
    if (tid < 256) { const float ss = WS4[0] + WS4[1] + WS4[2] + WS4[3]; const float rs = 1.0f / sqrtf(ss * (1.0f / 256.0f) + EPS);
        const float zz = bf_lo((unsigned)Z[row * 2048 + 256 * h + tid]);
        A2[row * 2048 + 256 * h + tid] = (bf16_t)(pk_bf16(RED[tid] * rs * gn[tid] * zz, 0.f) & 0xffffu); }
    __syncthreads();
}

DI void ln_row(bf16_t* gv, const float* g, const float* bta, float* outf, int lane) {
    u32x4 x[4]; float s = 0.f;
#pragma unroll
    for (int i = 0; i < 4; ++i) { x[i] = ((const u32x4*)gv)[lane + 64 * i];
#pragma unroll
        for (int e = 0; e < 4; ++e) s += bf_lo(x[i][e]) + bf_hi(x[i][e]); }
    const float mu = wave_sum(s) * (1.0f / 2048.0f); float q = 0.f;
#pragma unroll
    for (int i = 0; i < 4; ++i)
#pragma unroll
        for (int e = 0; e < 4; ++e) { const float a = bf_lo(x[i][e]) - mu, c = bf_hi(x[i][e]) - mu; q += a * a + c * c; }
    const float rstd = 1.0f / sqrtf(wave_sum(q) * (1.0f / 2048.0f) + EPS);
#pragma unroll
    for (int i = 0; i < 4; ++i) { const int c0 = 8 * (lane + 64 * i);
        const f32x4 g0 = *(const f32x4*)(g + c0), g1 = *(const f32x4*)(g + c0 + 4), b0 = *(const f32x4*)(bta + c0), b1 = *(const f32x4*)(bta + c0 + 4);
        f32x4 y0, y1;
        y0[0] = (bf_lo(x[i][0]) - mu) * rstd * g0[0] + b0[0]; y0[1] = (bf_hi(x[i][0]) - mu) * rstd * g0[1] + b0[1];
        y0[2] = (bf_lo(x[i][1]) - mu) * rstd * g0[2] + b0[2]; y0[3] = (bf_hi(x[i][1]) - mu) * rstd * g0[3] + b0[3];
        y1[0] = (bf_lo(x[i][2]) - mu) * rstd * g1[0] + b1[0]; y1[1] = (bf_hi(x[i][2]) - mu) * rstd * g1[1] + b1[1];
        y1[2] = (bf_lo(x[i][3]) - mu) * rstd * g1[2] + b1[2]; y1[3] = (bf_hi(x[i][3]) - mu) * rstd * g1[3] + b1[3];
        u32x4 o; o.x = pk_bf16(y0[0], y0[1]); o.y = pk_bf16(y0[2], y0[3]); o.z = pk_bf16(y1[0], y1[1]); o.w = pk_bf16(y1[2], y1[3]);
        ((u32x4*)gv)[lane + 64 * i] = o;
        if (outf) { *(f32x4*)(outf + c0) = y0; *(f32x4*)(outf + c0 + 4) = y1; } }
}

DI void ln_gate_sample_row(const bf16_t* gv, const bf16_t* uzrow, bf16_t* a2row, const float* g, const float* bta, const float* wsp, const float* bsp, float* outf, int lane) {
    u32x4 x[4]; float s = 0.f;
#pragma unroll
    for (int i = 0; i < 4; ++i) { x[i] = ((const u32x4*)gv)[lane + 64 * i];
#pragma unroll
        for (int e = 0; e < 4; ++e) s += bf_lo(x[i][e]) + bf_hi(x[i][e]); }
    const float mu = wave_sum(s) * (1.0f / 2048.0f); float q = 0.f;
#pragma unroll
    for (int i = 0; i < 4; ++i)
#pragma unroll
        for (int e = 0; e < 4; ++e) { const float a = bf_lo(x[i][e]) - mu, c = bf_hi(x[i][e]) - mu; q += a * a + c * c; }
    const float rstd = 1.0f / sqrtf(wave_sum(q) * (1.0f / 2048.0f) + EPS);
#pragma unroll
    for (int i = 0; i < 4; ++i) { const int c0 = 8 * (lane + 64 * i), grp = c0 >> 8; const float w00 = wsp[(size_t)grp * 128 * 128], b0s = bsp[grp * 128];
        const f32x4 g0 = *(const f32x4*)(g + c0), g1 = *(const f32x4*)(g + c0 + 4), b0 = *(const f32x4*)(bta + c0), b1 = *(const f32x4*)(bta + c0 + 4);
        f32x4 y0, y1;
        y0[0] = (bf_lo(x[i][0]) - mu) * rstd * g0[0] + b0[0]; y0[1] = (bf_hi(x[i][0]) - mu) * rstd * g0[1] + b0[1];
        y0[2] = (bf_lo(x[i][1]) - mu) * rstd * g0[2] + b0[2]; y0[3] = (bf_hi(x[i][1]) - mu) * rstd * g0[3] + b0[3];
        y1[0] = (bf_lo(x[i][2]) - mu) * rstd * g1[0] + b1[0]; y1[1] = (bf_hi(x[i][2]) - mu) * rstd * g1[1] + b1[1];
        y1[2] = (bf_lo(x[i][3]) - mu) * rstd * g1[2] + b1[2]; y1[3] = (bf_hi(x[i][3]) - mu) * rstd * g1[3] + b1[3];
        *(f32x4*)(outf + c0) = y0; *(f32x4*)(outf + c0 + 4) = y1;
        const u32x4 uz = *(const u32x4*)(uzrow + c0); u32x4 o;
        o.x = pk_bf16(bf_lo(uz.x) * (w00 * y0[0] + b0s), bf_hi(uz.x) * (w00 * y0[1] + b0s));
        o.y = pk_bf16(bf_lo(uz.y) * (w00 * y0[2] + b0s), bf_hi(uz.y) * (w00 * y0[3] + b0s));
        o.z = pk_bf16(bf_lo(uz.z) * (w00 * y1[0] + b0s), bf_hi(uz.z) * (w00 * y1[1] + b0s));
        o.w = pk_bf16(bf_lo(uz.w) * (w00 * y1[2] + b0s), bf_hi(uz.w) * (w00 * y1[3] + b0s));
        *(u32x4*)(a2row + c0) = o; }
}

constexpr int SP_WI = 0, SP_VI = 34816, SP_VIMG = 34816, SP_MU = 106496;
DI void spatial_item(LAS unsigned char* lds, const int w, int item, const float* Wsp, const float* bsp, const bf16_t* VN, const bf16_t* UZ, bf16_t* A2,
                     const float* LNST, const float* lng, const float* lnb, float* cvp  ) {
    const int lane = lane_id_v(), tid = w * 64 + lane, fr = lane & 15, fq = lane >> 4;
    const int g = item & 7, n = (item >> 3) & 15, b = item >> 7;
    const size_t row_base = (size_t)b * SEQ + (size_t)n * 128;
    LAS float* MU = (LAS float*)(lds + SP_MU);
    if (tid < 128) {
        const f32x4* p = (const f32x4*)(LNST + (row_base + tid) * 64); f32x4 t = p[0];
#pragma unroll
        for (int i = 1; i < 16; ++i) t += p[i];
        const float mu = (t[0] + t[2]) * (1.0f / 2048.0f), var = fmaxf((t[1] + t[3]) * (1.0f / 2048.0f) - mu * mu, 0.f);
        MU[tid] = mu; MU[128 + tid] = 1.0f / sqrtf(var + EPS);
    }
    __syncthreads();
    {
        const float* wg = Wsp + (size_t)g * 128 * 128;
#pragma unroll
        for (int i = 0; i < 4; ++i) { const int ci = tid + 512 * i, t = ci >> 4, ch = ci & 15;
            const f32x4 a = *(const f32x4*)(wg + t * 128 + 8 * ch), c = *(const f32x4*)(wg + t * 128 + 8 * ch + 4); const int s0 = 8 * ch;
            u32x4 o; o.x = pk_bf16(s0 + 0 <= t ? a[0] : 0.f, s0 + 1 <= t ? a[1] : 0.f); o.y = pk_bf16(s0 + 2 <= t ? a[2] : 0.f, s0 + 3 <= t ? a[3] : 0.f);
            o.z = pk_bf16(s0 + 4 <= t ? c[0] : 0.f, s0 + 5 <= t ? c[1] : 0.f); o.w = pk_bf16(s0 + 6 <= t ? c[2] : 0.f, s0 + 7 <= t ? c[3] : 0.f);
            *(LAS u32x4*)(lds + SP_WI + t * TS + ch * 16) = o; }
        const int c32 = tid & 31, cc = 256 * g + 8 * c32;
        const f32x4 g0 = *(const f32x4*)(lng + cc), g1 = *(const f32x4*)(lng + cc + 4), b0 = *(const f32x4*)(lnb + cc), b1 = *(const f32x4*)(lnb + cc + 4);
#pragma unroll
        for (int i = 0; i < 8; ++i) { const int s = (tid >> 5) + 16 * i;
            const u32x4 x = *(const u32x4*)(VN + (row_base + s) * 2048 + cc);
            const float mu = MU[s], rstd = MU[128 + s]; f32x4 y0, y1;
            y0[0] = (bf_lo(x.x) - mu) * rstd * g0[0] + b0[0]; y0[1] = (bf_hi(x.x) - mu) * rstd * g0[1] + b0[1]; y0[2] = (bf_lo(x.y) - mu) * rstd * g0[2] + b0[2]; y0[3] = (bf_hi(x.y) - mu) * rstd * g0[3] + b0[3];
            y1[0] = (bf_lo(x.z) - mu) * rstd * g1[0] + b1[0]; y1[1] = (bf_hi(x.z) - mu) * rstd * g1[1] + b1[1]; y1[2] = (bf_lo(x.w) - mu) * rstd * g1[2] + b1[2]; y1[3] = (bf_hi(x.w) - mu) * rstd * g1[3] + b1[3];
            if (n == 15) { float* o = cvp + ((size_t)b * 128 + s) * 2048 + cc; *(f32x4*)o = y0; *(f32x4*)(o + 4) = y1; }
            u32x4 o; o.x = pk_bf16(y0[0], y0[1]); o.y = pk_bf16(y0[2], y0[3]); o.z = pk_bf16(y1[0], y1[1]); o.w = pk_bf16(y1[2], y1[3]);
            *(LAS u32x4*)(lds + SP_VI + (c32 >> 4) * SP_VIMG + s * TS + (c32 & 15) * 16) = o; }
    }
    __syncthreads();
    f32x4 acc[8][2];
#pragma unroll
    for (int mt = 0; mt < 8; ++mt) { acc[mt][0] = (f32x4){0.f, 0.f, 0.f, 0.f}; acc[mt][1] = (f32x4){0.f, 0.f, 0.f, 0.f}; }
    LAS unsigned char* vtr = lds + SP_VI + (w >> 2) * SP_VIMG + (w & 3) * 64 + (8 * fq + ((lane & 15) >> 2)) * TS + (lane & 3) * 8;
    LAS unsigned char* wrb = lds + SP_WI + fr * TS + fq * 16;
#pragma unroll
    for (int ks = 0; ks < 4; ++ks) {
        const bf16x8 v0 = tr_frag2(vtr + ks * 32 * TS), v1 = tr_frag2(vtr + ks * 32 * TS + 32);
#pragma unroll
        for (int mt = 0; mt < 8; ++mt) {
            if (32 * ks > 16 * mt + 15) continue;
            const bf16x8 wf = *(LAS bf16x8*)(wrb + mt * 16 * TS + ks * 64);
            acc[mt][0] = mfma16(v0, wf, acc[mt][0]); acc[mt][1] = mfma16(v1, wf, acc[mt][1]);
        }
    }
    __syncthreads();
    {
        constexpr int SS = 528;
        const float* bg = bsp + g * 128;
#pragma unroll
        for (int mt = 0; mt < 8; ++mt) { const int t = 16 * mt + fr; const float bs = bg[t];
#pragma unroll
            for (int nt = 0; nt < 2; ++nt) { const f32x4 a = acc[mt][nt]; u32x2 o; o.x = pk_bf16(a[0] + bs, a[1] + bs); o.y = pk_bf16(a[2] + bs, a[3] + bs);
                *(LAS u32x2*)(lds + t * SS + (32 * w + 16 * nt + 4 * fq) * 2) = o; } }
        __syncthreads();
#pragma unroll
        for (int i = 0; i < 2; ++i) { const int task = tid + 512 * i, t = task >> 3, cg8 = task & 7;
            const size_t ro = (row_base + t) * 2048 + 256 * g + 32 * cg8;
            const u32x4* up = (const u32x4*)(UZ + ro); u32x4* op = (u32x4*)(A2 + ro);
#pragma unroll
            for (int q = 0; q < 4; ++q) { const u32x4 sv = *(LAS u32x4*)(lds + t * SS + (32 * cg8 + 8 * q) * 2); const u32x4 uu = up[q]; u32x4 o;
#pragma unroll
                for (int e = 0; e < 4; ++e) o[e] = pk_bf16(bf_lo(uu[e]) * bf_lo(sv[e]), bf_hi(uu[e]) * bf_hi(sv[e]));
                op[q] = o; } }
    }
    __syncthreads();
}

#define XB_TMO      128
#define XB_XCNT(j)  (256  + 64 * (j))
#define XB_XSUB(j)  (1280 + 64 * (j))
#define XB_XGEN(j)  (2304 + 64 * (j))
#define XB_TOP      3328
#define XB_TOPGEN   3392
#define XCD_BAR_WORDS 3456
#define XB_SPIN_CAP (1u << 18)
DI unsigned xb_ld(unsigned* p)              { return __hip_atomic_load(p, __ATOMIC_RELAXED, __HIP_MEMORY_SCOPE_AGENT); }
DI unsigned xb_add(unsigned* p, unsigned v) { return __hip_atomic_fetch_add(p, v, __ATOMIC_RELAXED, __HIP_MEMORY_SCOPE_AGENT); }
DI unsigned xb_xcc_id() { return (unsigned)__builtin_amdgcn_s_getreg((3 << 11) | 20) & 0xFu; }
#define XB_SPIN(cond, bar) do { unsigned _sp = 0; while (cond) { __builtin_amdgcn_s_sleep(1); \
    if ((++_sp & 255u) == 0u) { if (xb_ld(&(bar)[XB_TMO])) break; if (_sp > XB_SPIN_CAP) { atomicAdd(&(bar)[XB_TMO], 1u); break; } } } } while (0)
struct XcdBarrier { unsigned* bar; unsigned x; volatile LAS unsigned* st; };
DI XcdBarrier xcd_barrier_post(unsigned* bar, volatile LAS unsigned* st, bool leader) {
    XcdBarrier b; b.bar = bar; b.x = xb_xcc_id(); b.st = st;
    if (leader) (void)xb_add(&bar[XB_XCNT(b.x)], 1u);
    return b;
}
DI void xcd_barrier_complete(unsigned* bar, unsigned x, unsigned& nloc, unsigned& nx) {
    const unsigned G = gridDim.x * gridDim.y * gridDim.z;
    unsigned sum, cnt, mine, sp = 0u;
    for (;;) {
        sum = 0u; cnt = 0u; mine = 0u;
#pragma unroll
        for (unsigned j = 0; j < 16; ++j) { const unsigned c = xb_ld(&bar[XB_XCNT(j)]); sum += c; cnt += (c > 0u) ? 1u : 0u; mine = (j == x) ? c : mine; }
        if (sum == G) break;
        __builtin_amdgcn_s_sleep(1);
        if ((++sp & 255u) == 0u) { if (xb_ld(&bar[XB_TMO])) break; if (sp > XB_SPIN_CAP) { atomicAdd(&bar[XB_TMO], 1u); break; } }
    }
    nloc = mine > 0u ? mine : 1u; nx = cnt > 0u ? cnt : 1u;
}
DI void xcd_barrier(const XcdBarrier& b, const int wave) {
    asm volatile("s_waitcnt vmcnt(0)" ::: "memory");
    __syncthreads();
    if (wave == 0 && lane_id_v() == 0) {
        unsigned* bar = b.bar;
        __builtin_amdgcn_s_waitcnt(0);
        unsigned nloc = b.st[0], nx = b.st[1];
        if (nloc == 0u) { xcd_barrier_complete(bar, b.x, nloc, nx); b.st[0] = nloc; b.st[1] = nx; }
        const unsigned old = xb_add(&bar[XB_XSUB(b.x)], 1u);
        const unsigned gen = old / nloc;
        if (old + 1u == (gen + 1u) * nloc) {
            __builtin_amdgcn_fence(__ATOMIC_RELEASE, "agent");
            asm volatile("s_waitcnt vmcnt(0)" ::: "memory");
            const unsigned og = xb_add(&bar[XB_TOP], 1u);
            const unsigned tg = og / nx;
            if (og + 1u == (tg + 1u) * nx) xb_add(&bar[XB_TOPGEN], 1u);
            else XB_SPIN(xb_ld(&bar[XB_TOPGEN]) == tg, bar);
            __builtin_amdgcn_fence(__ATOMIC_ACQUIRE, "agent");
            xb_add(&bar[XB_XGEN(b.x)], 1u);
            asm volatile("s_waitcnt vmcnt(0)" ::: "memory");
        } else {
            XB_SPIN(xb_ld(&bar[XB_XGEN(b.x)]) == gen, bar);
            __builtin_amdgcn_fence(__ATOMIC_ACQUIRE, "agent");
            asm volatile("s_waitcnt vmcnt(0)" ::: "memory");
        }
    }
    __syncthreads();
}

struct Args { const float* in[20]; float* out; unsigned char* ws; int ph_lo, ph_hi; };
constexpr int N_PHASES = 2 + (4 + 4 + 5 + 4) + 1;
#define WSP(T, off) ((T*)(A->ws + (off)))
typedef const __attribute__((address_space(4))) Args KArgs;
DI KArgs* ka_ptr() { KArgs* p = (KArgs*)__builtin_amdgcn_kernarg_segment_ptr(); asm volatile("" : "+s"(p)); return p; }

__global__ void __launch_bounds__(NTHREADS, 2) fwd_kernel(Args args) {
    extern __shared__ __attribute__((aligned(16))) unsigned char lds_raw[];
    LAS unsigned char* lds = (LAS unsigned char*)lds_raw;
    const int wave = __builtin_amdgcn_readfirstlane(threadIdx.x >> 6);
    const int G = gridDim.x, bid = blockIdx.x;
    const int gw = bid * NWAVES + wave, NGW = G * NWAVES;
    const int lo = args.ph_lo, hi = args.ph_hi;

    volatile LAS unsigned* xst = (volatile LAS unsigned*)(lds + LDS_BYTES - 64);
    if (threadIdx.x < 2) xst[threadIdx.x] = 0u;
    __syncthreads();
    (void)xcd_barrier_post((unsigned*)(args.ws + WS_CTR), xst, threadIdx.x == 0);

    int ph = 0;
#define RUN_PHASE (lo <= ph && ph < hi)
#define SEAM() do { if (lo <= ph && ph + 1 < hi) { if (ka_ptr()->ph_lo < 0) cg::this_grid().sync(); else { XcdBarrier xb_; xb_.bar = (unsigned*)(ka_ptr()->ws + WS_CTR); xb_.x = xb_xcc_id(); xb_.st = (volatile LAS unsigned*)(lds + LDS_BYTES - 64); xcd_barrier(xb_, wave); } } ++ph; } while (0)

    if (RUN_PHASE) { KArgs* A = ka_ptr();
        const int lane = lane_id_v();
        LAS float* scr = (LAS float*)(lds + wave * 16384);
        constexpr int I_IN = 16 * 192, I_OUT = 32 * 32, I_G = 16 * 32, I_P = 4 * 32;
        constexpr int NITEMS = 4 * I_IN + 4 * I_OUT + 4 * I_G + 4 * I_P;
#define P0_DESC(d, it_) do { int r = (it_); \
            if (r < 2 * I_IN) { const int j = r / I_IN; d = TDesc{A->in[6] + (size_t)j * 1024 * 6144, WSP(bf16_t, WS_WINA) + (size_t)j * 6144 * 1024, A->in[5] + (2 * j) * 1024, 1024, 6144, r % I_IN, false}; break; } r -= 2 * I_IN; \
            if (r < 2 * I_IN) { const int j = r / I_IN; d = TDesc{A->in[10] + (size_t)j * 1024 * 6144, WSP(bf16_t, WS_WINB) + (size_t)j * 6144 * 1024, A->in[5] + (2 * j + 1) * 1024, 1024, 6144, r % I_IN, true}; break; } r -= 2 * I_IN; \
            if (r < 2 * I_OUT) { const int j = r / I_OUT; d = TDesc{A->in[9] + (size_t)j * 2048 * 1024, WSP(bf16_t, WS_WOUTA) + (size_t)j * 1024 * 2048, nullptr, 2048, 1024, r % I_OUT, false}; break; } r -= 2 * I_OUT; \
            if (r < 2 * I_OUT) { const int j = r / I_OUT; d = TDesc{A->in[15] + (size_t)j * 2048 * 1024, WSP(bf16_t, WS_WOUTB) + (size_t)j * 1024 * 2048, nullptr, 2048, 1024, r % I_OUT, false}; break; } r -= 2 * I_OUT; \
            if (r < 4 * I_G) { const int j = r / I_G; d = TDesc{A->in[17] + (size_t)j * 1024 * 1024, WSP(bf16_t, WS_WG) + (size_t)j * 1024 * 1024, A->in[16] + j * 1024, 1024, 1024, r % I_G, false}; break; } r -= 4 * I_G; \
            { const int j = r / I_P; d = TDesc{A->in[18] + (size_t)j * 256 * 1024, WSP(bf16_t, WS_WP) + (size_t)j * 1024 * 256, nullptr, 256, 1024, r % I_P, false}; } } while (0)
        if (gw < NITEMS) {
            int it = gw; TDesc cur; P0_DESC(cur, it);
            f32x4 v[8]; float sc[8]; t_load(cur, lane, v, sc);
            for (;;) {
                const int nx = it + NGW; const bool hn = nx < NITEMS;
                TDesc nd = cur; f32x4 vn[8]; float scn[8];
                if (hn) { P0_DESC(nd, nx); t_load(nd, lane, vn, scn); }
                t_store(cur, scr, lane, v, sc);
                if (!hn) break;
                cur = nd; it = nx;
#pragma unroll
                for (int i = 0; i < 8; ++i) { v[i] = vn[i]; sc[i] = scn[i]; }
            }
        }
#undef P0_DESC
        for (int m = gw; m < MR; m += NGW) {
            const float* src = m < MP ? A->in[0] + (size_t)m * 1024 : A->in[1] + (size_t)(m - MP) * 1024;
            float ss = 0.f;
#pragma unroll
            for (int jq = 0; jq < 4; ++jq) { const f32x4 v = ((const f32x4*)src)[lane + 64 * jq]; ss += (v[0] * v[0] + v[1] * v[1]) + (v[2] * v[2] + v[3] * v[3]);
                u32x2 w; w.x = pk_bf16(v[0], v[1]); w.y = pk_bf16(v[2], v[3]); ((u32x2*)(WSP(bf16_t, WS_HB) + (size_t)m * 1024))[lane + 64 * jq] = w; }
            ss = wave_sum(ss);
            const float one = (lane == 0) ? ss : 0.f;
            if (m < MP) { if (lane < 16) WSP(float, WS_SSPB)[(size_t)m * 16 + lane] = one; }
            else WSP(float, WS_SSSB)[(size_t)(m - MP) * 64 + lane] = one;
        }
        for (int idx = gw; idx < 4 * MPAD; idx += NGW) {
            const int i = idx / MPAD, m = idx % MPAD;
            f32x4 v = (f32x4){0.f, 0.f, 0.f, 0.f};
            if (m < MP) v = ((const f32x4*)(A->in[3] + ((size_t)i * MP + m) * 256))[lane];
            else if (m < MR) v = ((const f32x4*)(A->in[4] + ((size_t)i * NSMP + (m - MP)) * 256))[lane];
            u32x2 o; o.x = pk_bf16(v[0], v[1]); o.y = pk_bf16(v[2], v[3]);
            ((u32x2*)(WSP(bf16_t, WS_PB) + (size_t)idx * 256))[lane] = o;
        }
        if (bid == 0) { const float* lb_logits = A->in[7]; float* LB = WSP(float, WS_LB);
            for (int c = wave * 64 + lane; c < 1024; c += NTHREADS) {
                const float l0 = lb_logits[c], l1 = lb_logits[1024 + c], mx = fmaxf(l0, l1), e0 = expf(l0 - mx), e1 = expf(l1 - mx), s0 = e0 / (e0 + e1), s1 = e1 / (e0 + e1);
                const float c0 = s0, c1 = s0 + s1; LB[c] = c0 - c0; LB[1024 + c] = c1 - c0; } }
    }
    SEAM();
    if (RUN_PHASE) { KArgs* A = ka_ptr();
        { pg8::Gemm g{WSP(bf16_t, WS_PB), WSP(bf16_t, WS_WP), (size_t)MPAD * 256 * 2, (size_t)1024 * 256 * 2}; pg8::Order S; S.init(MP, 1024, 4, G, bid); pg8::EpiPle E{WSP(bf16_t, WS_PLE)}; pg8::gemm_phase<256>(lds, wave, g, S, E);
          TEpiPle TE{WSP(bf16_t, WS_PLE)}; thin_gemm<256, 1, 8>(lds, wave, WSP(bf16_t, WS_PB) + (size_t)MP * 256, (size_t)MPAD * 256, WSP(bf16_t, WS_WP), (size_t)1024 * 256, 1024, 4, bid, G, TE); }
        { pg8::Gemm g{WSP(bf16_t, WS_HB), WSP(bf16_t, WS_WINA), 0, 0}; pg8::Order S; S.init(MP, 6144, 1, G, bid);
          pg8::EpiInA E{WSP(bf16_t, WS_Q), WSP(f16_t, WS_LOGF), WSP(bf16_t, WS_V), WSP(bf16_t, WS_Z), WSP(float, WS_LB), WSP(float, WS_SSPB)}; pg8::gemm_phase<1024>(lds, wave, g, S, E);
          TEpiInA TE{WSP(bf16_t, WS_Q), WSP(f16_t, WS_LOGF), WSP(bf16_t, WS_V), WSP(bf16_t, WS_Z), WSP(float, WS_LB), WSP(float, WS_SSSB)}; thin_gemm<1024, 2, 8>(lds, wave, WSP(bf16_t, WS_HB) + (size_t)MP * 1024, 0, WSP(bf16_t, WS_WINA), 0, 6144, 1, bid, G, TE); }
    }
    SEAM();
#pragma unroll 1
    for (int li = 0; li < 4; ++li) {
        const int j = li >> 1;
        if ((li & 1) == 0) {
            if (li > 0) {
                if (RUN_PHASE) { KArgs* A = ka_ptr(); pg8::Gemm g{WSP(bf16_t, WS_HB), WSP(bf16_t, WS_WINA) + (size_t)j * 6144 * 1024, 0, 0}; pg8::Order S; S.init(MP, 6144, 1, G, bid);
                    pg8::EpiInA E{WSP(bf16_t, WS_Q), WSP(f16_t, WS_LOGF), WSP(bf16_t, WS_V), WSP(bf16_t, WS_Z), WSP(float, WS_LB) + j * 1024, WSP(float, WS_SSPB)}; pg8::gemm_phase<1024>(lds, wave, g, S, E);
                    TEpiInA TE{WSP(bf16_t, WS_Q), WSP(f16_t, WS_LOGF), WSP(bf16_t, WS_V), WSP(bf16_t, WS_Z), WSP(float, WS_LB) + j * 1024, WSP(float, WS_SSSB)}; thin_gemm<1024, 2, 8>(lds, wave, WSP(bf16_t, WS_HB) + (size_t)MP * 1024, 0, WSP(bf16_t, WS_WINA) + (size_t)j * 6144 * 1024, 0, 6144, 1, bid, G, TE); }
                SEAM();
            }
            if (RUN_PHASE) { KArgs* A = ka_ptr();
                const float* gn = A->in[8] + j * 256;
                const float* s0 = A->in[2] + (size_t)j * 128 * 8 * 128 * 256; float* s1 = A->out + OUT_SS + (size_t)j * 128 * 8 * 128 * 256;
                const bf16_t* Qb = WSP(bf16_t, WS_Q); const f16_t* LOGF = WSP(f16_t, WS_LOGF); const bf16_t* Vb = WSP(bf16_t, WS_V); const bf16_t* Zb = WSP(bf16_t, WS_Z); bf16_t* A2 = WSP(bf16_t, WS_A2);
                for (int it = bid; it < 64 * (NSEG - 1); it += G) scan_prompt<1>(lds, wave, it & 63, it >> 6, Qb, LOGF, Vb, Zb, A2, gn, nullptr, WSP(float, WS_SL), WSP(float, WS_DSEG));
                if (G == 256) {
                    if (bid >= 192) for (int it = 4 * (bid - 192); it < 4 * (bid - 192) + 4; ++it) scan_sample(lds, wave, it, Qb, LOGF, Vb, Zb, A2, gn, s0, s1);
                } else for (int it = bid; it < NSMP * 8; it += G) scan_sample(lds, wave, it, Qb, LOGF, Vb, Zb, A2, gn, s0, s1);
            }
            SEAM();
            if (RUN_PHASE) { KArgs* A = ka_ptr();
                const float* gn = A->in[8] + j * 256;
                float* sp_out = A->out + OUT_SP + (size_t)j * 8 * 8 * 128 * 256;
                const bf16_t* Qb = WSP(bf16_t, WS_Q); const f16_t* LOGF = WSP(f16_t, WS_LOGF); const bf16_t* Vb = WSP(bf16_t, WS_V); const bf16_t* Zb = WSP(bf16_t, WS_Z); bf16_t* A2 = WSP(bf16_t, WS_A2);
                for (int it = bid; it < 64 * NSEG; it += G) scan_prompt<0>(lds, wave, it & 63, it >> 6, Qb, LOGF, Vb, Zb, A2, gn, sp_out, WSP(float, WS_SL), WSP(float, WS_DSEG));
                if (G == 256) {
                    const float* s0 = A->in[2] + (size_t)j * 128 * 8 * 128 * 256; float* s1 = A->out + OUT_SS + (size_t)j * 128 * 8 * 128 * 256;
                    for (int it = 256 + 3 * bid; it < 256 + 3 * bid + 3; ++it) scan_sample(lds, wave, it, Qb, LOGF, Vb, Zb, A2, gn, s0, s1);
                }
            }
            SEAM();
        } else {
            if (RUN_PHASE) { KArgs* A = ka_ptr(); pg8::Gemm g{WSP(bf16_t, WS_HB), WSP(bf16_t, WS_WINB) + (size_t)j * 6144 * 1024, 0, 0}; pg8::Order S; S.init(MP, 6144, 1, G, bid);
                pg8::EpiInB E{WSP(bf16_t, WS_U), WSP(bf16_t, WS_V), WSP(float, WS_SSPB), WSP(float, WS_LNST)}; pg8::gemm_phase<1024>(lds, wave, g, S, E);
                TEpiInB TE{WSP(bf16_t, WS_U), WSP(bf16_t, WS_V), WSP(float, WS_SSSB)}; thin_gemm<1024, 2, 8>(lds, wave, WSP(bf16_t, WS_HB) + (size_t)MP * 1024, 0, WSP(bf16_t, WS_WINB) + (size_t)j * 6144 * 1024, 0, 6144, 1, bid, G, TE); }
            SEAM();
            if (RUN_PHASE) { KArgs* A = ka_ptr();
                const float* wsp = A->in[13] + (size_t)j * 8 * 128 * 128; const float* bsp = A->in[14] + j * 8 * 128;
                const float* lng = A->in[11] + j * 2048; const float* lnb = A->in[12] + j * 2048;
                const bf16_t* Vb = WSP(bf16_t, WS_V); const bf16_t* Ub = WSP(bf16_t, WS_U); bf16_t* A2 = WSP(bf16_t, WS_A2);
                for (int it = bid; it < NB * 16 * 8; it += G) spatial_item(lds, wave, it, wsp, bsp, Vb, Ub, A2, WSP(float, WS_LNST), lng, lnb, A->out + OUT_CVP + (size_t)j * NB * 128 * 2048);
                const int lane = lane_id_v();
                for (int r = gw; r < NSMP; r += NGW) { const size_t ro = (size_t)(MP + r) * 2048;
                    ln_gate_sample_row(Vb + ro, Ub + ro, A2 + ro, lng, lnb, wsp, bsp, A->out + OUT_CVS + ((size_t)j * NSMP + r) * 2048, lane); }
            }
            SEAM();
        }
        if (RUN_PHASE) { KArgs* A = ka_ptr(); pg8::Gemm g{WSP(bf16_t, WS_A2), ((li & 1) ? WSP(bf16_t, WS_WOUTB) : WSP(bf16_t, WS_WOUTA)) + (size_t)j * 1024 * 2048, 0, 0}; pg8::Order S; S.init(MP, 1024, 1, G, bid);
            pg8::EpiRes E{li == 0 ? A->in[0] : nullptr, WSP(bf16_t, WS_HB), WSP(bf16_t, WS_HBA), WSP(float, WS_SSPA)}; pg8::gemm_phase<2048>(lds, wave, g, S, E);
            TEpiRes TE{li == 0 ? A->in[1] - (size_t)MP * 1024 : nullptr, WSP(bf16_t, WS_HB), WSP(bf16_t, WS_HBA), WSP(float, WS_SSSA)}; thin_gemm<2048, 1, 2>(lds, wave, WSP(bf16_t, WS_A2) + (size_t)MP * 2048, 0, ((li & 1) ? WSP(bf16_t, WS_WOUTB) : WSP(bf16_t, WS_WOUTA)) + (size_t)j * 1024 * 2048, 0, 1024, 1, bid, G, TE); }
        SEAM();
        if (RUN_PHASE) { KArgs* A = ka_ptr(); pg8::Gemm g{WSP(bf16_t, WS_HBA), WSP(bf16_t, WS_WG) + (size_t)li * 1024 * 1024, 0, 0}; pg8::Order S; S.init(MP, 1024, 1, G, bid);
            pg8::EpiGate E{WSP(bf16_t, WS_HBA), WSP(bf16_t, WS_PLE) + (size_t)li * MPAD * 1024, WSP(float, WS_SSPA), WSP(bf16_t, WS_HB), WSP(float, WS_H), WSP(float, WS_SSPB)}; pg8::gemm_phase<1024>(lds, wave, g, S, E);
            TEpiGate TE{WSP(bf16_t, WS_HBA), WSP(bf16_t, WS_PLE) + (size_t)li * MPAD * 1024, WSP(float, WS_SSSA), WSP(bf16_t, WS_HB), WSP(float, WS_H), WSP(float, WS_SSSB)}; thin_gemm<1024, 1, 2>(lds, wave, WSP(bf16_t, WS_HBA) + (size_t)MP * 1024, 0, WSP(bf16_t, WS_WG) + (size_t)li * 1024 * 1024, 0, 1024, 1, bid, G, TE); }
        SEAM();
    }
    if (RUN_PHASE) { KArgs* A = ka_ptr();
        const int lane = lane_id_v();
        for (int m = gw; m < MR; m += NGW) {
            float t = m < MP ? (lane < 16 ? WSP(float, WS_SSPB)[(size_t)m * 16 + lane] : 0.f) : WSP(float, WS_SSSB)[(size_t)(m - MP) * 64 + lane];
            const float rs = 1.0f / sqrtf(wave_sum(t) * (1.0f / 1024.0f) + EPS);
            const u32x2* hb = (const u32x2*)(WSP(bf16_t, WS_HB) + (size_t)m * 1024); const f32x4* gf = (const f32x4*)A->in[19]; f32x4* yo = (f32x4*)(A->out + OUT_Y + (size_t)m * 1024);
#pragma unroll
            for (int jq = 0; jq < 4; ++jq) { const u32x2 h = hb[lane + 64 * jq]; const f32x4 g4 = gf[lane + 64 * jq];
                yo[lane + 64 * jq] = (f32x4){bf_lo(h.x) * rs * g4[0], bf_hi(h.x) * rs * g4[1], bf_lo(h.y) * rs * g4[2], bf_hi(h.y) * rs * g4[3]}; }
        }
    }
    SEAM();
#undef RUN_PHASE
#undef SEAM
}

extern "C" void kernel_launch(void* const* d_in, const int* in_sizes, int n_in, void* d_out, int out_size, void* d_ws, size_t ws_size, hipStream_t stream) {
    static int grid = 0;
    if (grid == 0) {
        if (n_in != 20 || (size_t)out_size != OUT_END || ws_size < WS_END) { fprintf(stderr, "kernel_launch: unexpected shapes (n_in %d, out %d, ws %zu; need %zu)\n", n_in, out_size, ws_size, (size_t)WS_END); grid = -1; return; }
        int dev = 0, cus = 0, per_cu = 0;
        (void)hipGetDevice(&dev); (void)hipDeviceGetAttribute(&cus, hipDeviceAttributeMultiprocessorCount, dev);
        if (hipFuncSetAttribute((const void*)fwd_kernel, hipFuncAttributeMaxDynamicSharedMemorySize, LDS_BYTES) != hipSuccess) { fprintf(stderr, "kernel_launch: hipFuncSetAttribute failed\n"); grid = -1; return; }
        if (hipOccupancyMaxActiveBlocksPerMultiprocessor(&per_cu, (const void*)fwd_kernel, NTHREADS, LDS_BYTES) != hipSuccess || per_cu < 1) { fprintf(stderr, "kernel_launch: occupancy query gave %d\n", per_cu); per_cu = 1; }
        (void)hipGetLastError();
        grid = cus * per_cu;
    }
    if (grid < 0) return;
    if (hipMemsetAsync((char*)d_ws + WS_CTR, 0, 16384, stream) != hipSuccess) { fprintf(stderr, "kernel_launch: memset of the barrier words failed\n"); return; }
    Args a{};
    for (int i = 0; i < 20; ++i) a.in[i] = (const float*)d_in[i];
    a.out = (float*)d_out; a.ws = (unsigned char*)d_ws;
#if N_LAUNCH_MODE == 1
    a.ph_lo = 0; a.ph_hi = N_PHASES;
    void* kargs[] = {&a};
    hipError_t e = hipLaunchCooperativeKernel((const void*)fwd_kernel, dim3(grid), dim3(NTHREADS), kargs, LDS_BYTES, stream);
    if (e != hipSuccess) fprintf(stderr, "kernel_launch: cooperative launch failed: %s (grid %d)\n", hipGetErrorString(e), grid);
#else
    for (int p = 0; p < N_PHASES; ++p) { a.ph_lo = p; a.ph_hi = p + 1; hipLaunchKernelGGL(fwd_kernel, dim3(grid), dim3(NTHREADS), LDS_BYTES, stream, a); }
#endif
}
```

```cpp
#include <hip/hip_runtime.h>
#include <hip/hip_cooperative_groups.h>
#include <cstdio>
#include <cstdint>
namespace cg = cooperative_groups;

#ifndef N_LAUNCH_MODE
#define N_LAUNCH_MODE 1
#endif

#ifndef REP_SCAN
#define REP_SCAN 1
#endif
#ifndef REP_INPROJ
#define REP_INPROJ 1
#endif
#ifndef REP_NORM
#define REP_NORM 1
#endif
#ifndef REP_SPATIAL
#define REP_SPATIAL 1
#endif
#ifndef REP_SYNC
#define REP_SYNC 1
#endif
#define DI __device__ __forceinline__
#define LAS __attribute__((address_space(3)))
typedef unsigned short bf16_t;
typedef short bf16x8 __attribute__((ext_vector_type(8)));
typedef short s16x4 __attribute__((ext_vector_type(4)));
typedef float f32x4 __attribute__((ext_vector_type(4)));
typedef unsigned u32x4 __attribute__((ext_vector_type(4)));
typedef unsigned u32x2 __attribute__((ext_vector_type(2)));

constexpr int DM = 1024, SEQ = 2048, NB = 8, NSMP = 128, DI_ = 2048, NH = 8, DK = 128, DV = 256, PLE_D = 256;
constexpr int MP = NB * SEQ;
constexpr int MR = MP + NSMP;
constexpr int MPAD = 16640;
constexpr float EPS = 1e-6f;
constexpr int NTHREADS = 512, NWAVES = 8;
constexpr int LDS_BYTES = 147456;

constexpr size_t SZ_WIN = (size_t)6144 * 1024 * 2, SZ_WOUT = (size_t)1024 * 2048 * 2, SZ_WG = (size_t)1024 * 1024 * 2, SZ_WP = (size_t)1024 * 256 * 2;
constexpr size_t WS_WINA = 0;
constexpr size_t WS_WOUTA = WS_WINA + 2 * SZ_WIN;
constexpr size_t WS_WINB = WS_WOUTA + 2 * SZ_WOUT;
constexpr size_t WS_WOUTB = WS_WINB + 2 * SZ_WIN;
constexpr size_t WS_WG = WS_WOUTB + 2 * SZ_WOUT;
constexpr size_t WS_WP = WS_WG + 4 * SZ_WG;
constexpr size_t WS_LB = WS_WP + 4 * SZ_WP;
constexpr size_t WS_H = WS_LB + 8192;
constexpr size_t WS_HB = WS_H + (size_t)MPAD * 1024 * 4;
constexpr size_t WS_PB = WS_HB + (size_t)MPAD * 1024 * 2;
constexpr size_t WS_PLE = WS_PB + (size_t)4 * MPAD * 256 * 2;
constexpr size_t WS_Q = WS_PLE + (size_t)4 * MPAD * 1024 * 2;
constexpr size_t WS_LOGF = WS_Q + (size_t)MPAD * 1024 * 2;
constexpr size_t WS_V = WS_LOGF + (size_t)MPAD * 1024 * 4;
constexpr size_t WS_Z = WS_V + (size_t)MPAD * 2048 * 2;
constexpr size_t WS_U = WS_Z + (size_t)MPAD * 2048 * 2;
constexpr size_t WS_A2 = WS_U + (size_t)MPAD * 2048 * 2;
constexpr size_t WS_SL = WS_A2 + (size_t)MPAD * 2048 * 2;
constexpr size_t WS_DSEG = WS_SL + (size_t)64 * 3 * 128 * 256 * 4;
constexpr size_t WS_CTR = WS_DSEG + (size_t)64 * 3 * 128 * 4;
constexpr size_t WS_HBA = WS_CTR + 16384;
constexpr size_t WS_SSPA = WS_HBA + (size_t)MPAD * 1024 * 2;
constexpr size_t WS_SSPB = WS_SSPA + (size_t)MP * 16 * 4;
constexpr size_t WS_SSSA = WS_SSPB + (size_t)MP * 16 * 4;
constexpr size_t WS_SSSB = WS_SSSA + (size_t)128 * 64 * 4;
constexpr size_t WS_LNST = WS_SSSB + (size_t)128 * 64 * 4;
constexpr size_t WS_END = WS_LNST + (size_t)MP * 64 * 4;

constexpr size_t OUT_Y = 0;
constexpr size_t OUT_SP = (size_t)MR * 1024;
constexpr size_t OUT_SS = OUT_SP + (size_t)2 * 8 * 8 * 128 * 256;
constexpr size_t OUT_CVP = OUT_SS + (size_t)2 * 128 * 8 * 128 * 256;
constexpr size_t OUT_CVS = OUT_CVP + (size_t)2 * 8 * 128 * 2048;
constexpr size_t OUT_END = OUT_CVS + (size_t)2 * 128 * 2048;

typedef __bf16 bf16x2_t __attribute__((ext_vector_type(2)));
typedef float f32x2_t __attribute__((ext_vector_type(2)));
DI unsigned pk_bf16(float lo, float hi) { const bf16x2_t r = __builtin_convertvector((f32x2_t){lo, hi}, bf16x2_t); return __builtin_bit_cast(unsigned, r); }
typedef _Float16 h16x2_t __attribute__((ext_vector_type(2)));
typedef unsigned short f16_t;
DI unsigned pk_f16(float lo, float hi) { const h16x2_t r = __builtin_convertvector((f32x2_t){lo, hi}, h16x2_t); return __builtin_bit_cast(unsigned, r); }
DI float f16_lo(unsigned u) { const h16x2_t r = __builtin_bit_cast(h16x2_t, u); return (float)r[0]; }
DI float f16_hi(unsigned u) { const h16x2_t r = __builtin_bit_cast(h16x2_t, u); return (float)r[1]; }
DI float bf_lo(unsigned u) { return __uint_as_float(u << 16); }
DI float bf_hi(unsigned u) { return __uint_as_float(u & 0xffff0000u); }
DI int lane_id_v() { int l; asm volatile("v_mbcnt_lo_u32_b32 %0, -1, 0\n\tv_mbcnt_hi_u32_b32 %0, -1, %0" : "=v"(l)); return l; }
DI float sigm(float x) { return __builtin_amdgcn_rcpf(1.0f + __expf(-x)); }
DI float silu_f(float x) { return x * sigm(x); }
DI float gelu_f(float x) { const float u = 1.5957691216f * (x + 0.044715f * x * x * x); return x * sigm(u); }
DI float wave_sum(float v) {
#pragma unroll
    for (int o = 1; o < 64; o <<= 1) v += __shfl_xor(v, o);
    return v;
}
template <int ACT> DI float act_f(float x) { if (ACT == 1) return silu_f(x); if (ACT == 2) return gelu_f(x); return x; }
constexpr unsigned TS = 272;
DI unsigned off_b(unsigned row, unsigned ch) { return TS * row + 16u * ch; }
DI unsigned tr_addr16(unsigned lane, unsigned c, unsigned ks, unsigned t) {
    const unsigned g = lane >> 4, q = (lane & 15) >> 2, p = lane & 3;
    return off_b(32 * ks + 8 * g + 4 * t + q, 2 * c + (p >> 1)) + 8 * (p & 1);
}
DI bf16x8 tr_frag(LAS unsigned char* img, unsigned lane, unsigned c, unsigned ks) {
    const s16x4 a = __builtin_amdgcn_ds_read_tr16_b64_v4i16((LAS s16x4*)(img + tr_addr16(lane, c, ks, 0)));
    const s16x4 b = __builtin_amdgcn_ds_read_tr16_b64_v4i16((LAS s16x4*)(img + tr_addr16(lane, c, ks, 1)));
    return (bf16x8){a[0], a[1], a[2], a[3], b[0], b[1], b[2], b[3]};
}
DI f32x4 mfma16(bf16x8 a, bf16x8 b, f32x4 c) { return __builtin_amdgcn_mfma_f32_16x16x32_bf16(a, b, c, 0, 0, 0); }

namespace pg8 {
constexpr int BM = 256, BK = 64, HALF = 128, HTB = HALF * BK * 2, STAGE_BYTES = 8 * HTB, NXCD = 8, WGM = 8;
DI int lds_byte(int r, int c) { const int st = (r >> 4) * 2 + (c >> 5), rr = r & 15, cc = c & 31, ob = rr * 64 + cc * 2; return st * 1024 + (ob ^ (((ob >> 9) & 1) << 5)); }
DI void stage_rc(int b, int& R, int& C) { const int st = b / 1024, sb = b % 1024, swz = sb ^ (((sb >> 9) & 1) << 5); R = (st >> 1) * 16 + swz / 64; C = (st & 1) * 32 + (swz % 64) / 2; }
DI int perm32(int rho) { const int n = rho >> 4, i = rho & 15; return 8 * (i >> 2) + 4 * n + (i & 3); }

struct Unit { int pm, pn, z; };
struct Gemm { const bf16_t* A; const bf16_t* Bt; size_t Az, Bz; };
struct Order {
    int nM, nN, nZ, nwg, G, c;
    DI void init(int M, int N, int Z, int G_, int c_) { nM = M / BM; nN = N / BM; nZ = Z; nwg = nM * nN; G = G_; c = c_; }
    DI bool next(int i, Unit& u) const {
        const long L = (long)i * G + c; if (L >= (long)nwg * nZ) return false;
        u.z = (int)(L / nwg); int wgid = (int)(L % nwg);
        { const int q = nwg / NXCD, r = nwg % NXCD, xcd = wgid % NXCD, off = wgid / NXCD; wgid = (xcd < r ? xcd * (q + 1) : r * (q + 1) + (xcd - r) * q) + off; }
        const int nig = WGM * nN, gid = wgid / nig, fm = gid * WGM, gsz = (nM - fm) < WGM ? (nM - fm) : WGM;
        u.pm = fm + ((wgid % nig) % gsz); u.pn = (wgid % nig) / gsz; return true;
    }
};

DI void load_rs(const float* SSP, int row0, float (&rs)[2][4]) {
#pragma unroll
    for (int ai = 0; ai < 2; ++ai)
#pragma unroll
        for (int m = 0; m < 4; ++m) { const f32x4* p = (const f32x4*)(SSP + (size_t)(row0 + ai * HALF + m * 16) * 16); const f32x4 a = p[0], b = p[1], c = p[2], d = p[3];
            const float t = ((a[0] + a[1]) + (a[2] + a[3])) + ((b[0] + b[1]) + (b[2] + b[3])) + ((c[0] + c[1]) + (c[2] + c[3])) + ((d[0] + d[1]) + (d[2] + d[3]));
            rs[ai][m] = 1.0f / sqrtf(t * (1.0f / 1024.0f) + EPS); }
}
constexpr int RSN_OFF = 131072;
struct RsPre { f32x4 a, b, c, d; };
DI RsPre rs_pre_load(const float* SSP, int pm, int tid) { RsPre r; const f32x4* p = (const f32x4*)(SSP + (size_t)(pm * BM + (tid & 255)) * 16); r.a = p[0]; r.b = p[1]; r.c = p[2]; r.d = p[3]; return r; }
DI void rs_pre_store(LAS unsigned char* lds, const RsPre& r, int slot, int tid) {
    const float t = ((r.a[0] + r.a[1]) + (r.a[2] + r.a[3])) + ((r.b[0] + r.b[1]) + (r.b[2] + r.b[3])) + ((r.c[0] + r.c[1]) + (r.c[2] + r.c[3])) + ((r.d[0] + r.d[1]) + (r.d[2] + r.d[3]));
    if (tid < 256) ((LAS float*)(lds + RSN_OFF))[slot * 256 + tid] = 1.0f / sqrtf(t * (1.0f / 1024.0f) + EPS);
}
DI void load_rs_lds(LAS unsigned char* lds, int slot, int wr, int fr, float (&rs)[2][4]) {
#pragma unroll
    for (int ai = 0; ai < 2; ++ai)
#pragma unroll
        for (int m = 0; m < 4; ++m) rs[ai][m] = ((LAS float*)(lds + RSN_OFF))[slot * 256 + ai * HALF + wr * 64 + m * 16 + fr];
}
template <int ACT> DI void store_bf16_tile(const f32x4 (&acc)[2][2][4][2], bf16_t* dst, int ld, const float (&rs)[2][4], size_t bjs = HALF) {
#pragma unroll
    for (int ai = 0; ai < 2; ++ai)
#pragma unroll
        for (int m = 0; m < 4; ++m) { bf16_t* rp = dst + (size_t)(ai * HALF + m * 16) * ld;
#pragma unroll
            for (int bj = 0; bj < 2; ++bj) { const f32x4 v0 = acc[ai][bj][m][0] * rs[ai][m], v1 = acc[ai][bj][m][1] * rs[ai][m];
                u32x4 w; w.x = pk_bf16(act_f<ACT>(v0[0]), act_f<ACT>(v0[1])); w.y = pk_bf16(act_f<ACT>(v0[2]), act_f<ACT>(v0[3]));
                w.z = pk_bf16(act_f<ACT>(v1[0]), act_f<ACT>(v1[1])); w.w = pk_bf16(act_f<ACT>(v1[2]), act_f<ACT>(v1[3]));
                *(u32x4*)(rp + bj * bjs) = w; } }
}
struct EpiInA {
    static constexpr bool PERM = true;
    static constexpr bool HAS_PRE = true;
    bf16_t* Q; f16_t* LOGF; bf16_t* V; bf16_t* Z; const float* lb; const float* SSP;
    DI void operator()(const f32x4 (&acc)[2][2][4][2], const Unit& u, int wr, int wc, int fr, int fq, LAS unsigned char* lds, int slot) const {
        const int row0 = u.pm * BM + wr * 64 + fr, colt = u.pn * BM, cl = wc * 32 + 8 * fq;
        float rs[2][4]; load_rs_lds(lds, slot, wr, fr, rs);
        const size_t bb = (size_t)(u.pm >> 3) * 8; const int t0 = (u.pm & 7) * BM + wr * 64 + fr;
        if (colt < 1024) store_bf16_tile<1>(acc, Q + ((bb + (colt >> 7)) * SEQ + t0) * 128 + cl, 128, rs, (size_t)SEQ * 128);
        else if (colt < 2048) {
            const int c0 = colt - 1024 + cl;
#pragma unroll
            for (int bj = 0; bj < 2; ++bj)
#pragma unroll
                for (int n = 0; n < 2; ++n) { const f32x4 lbv = *(const f32x4*)(lb + c0 + bj * HALF + 4 * n);
#pragma unroll
                    for (int ai = 0; ai < 2; ++ai)
#pragma unroll
                        for (int m = 0; m < 4; ++m) { const f32x4 x = acc[ai][bj][m][n] * rs[ai][m]; f32x4 o;
#pragma unroll
                            for (int e = 0; e < 4; ++e) { const float f = lbv[e] + (1.0f - lbv[e]) * sigm(x[e]); o[e] = __logf(f); }
                            u32x2 oh; oh.x = pk_f16(o[0], o[1]); oh.y = pk_f16(o[2], o[3]);
                            *(u32x2*)(LOGF + ((bb + ((colt - 1024) >> 7) + bj) * SEQ + t0 + ai * HALF + m * 16) * 128 + cl + 4 * n) = oh; } }
        }
        else if (colt < 4096) store_bf16_tile<0>(acc, V + ((bb + ((colt - 2048) >> 8)) * SEQ + t0) * 256 + cl, 256, rs);
        else store_bf16_tile<1>(acc, Z + ((bb + ((colt - 4096) >> 8)) * SEQ + t0) * 256 + cl, 256, rs);
    }
};
struct EpiInB {
    static constexpr bool PERM = true;
    static constexpr bool HAS_PRE = true;
    bf16_t* UZ; bf16_t* GV; const float* SSP; float* LNST;
    DI void operator()(const f32x4 (&acc)[2][2][4][2], const Unit& u, int wr, int wc, int fr, int fq, LAS unsigned char* lds, int slot_rs) const {
        const int row0 = u.pm * BM + wr * 64 + fr, colt = u.pn * BM, cl = wc * 32 + 8 * fq;
        float rs[2][4]; load_rs_lds(lds, slot_rs, wr, fr, rs);
        if (colt < 4096) {
            bf16_t* dst = UZ + (size_t)row0 * 2048 + ((colt + cl) >> 1);
#pragma unroll
            for (int ai = 0; ai < 2; ++ai)
#pragma unroll
                for (int m = 0; m < 4; ++m) { bf16_t* rp = dst + (size_t)(ai * HALF + m * 16) * 2048;
#pragma unroll
                    for (int bj = 0; bj < 2; ++bj) { const f32x4 v0 = acc[ai][bj][m][0] * rs[ai][m], v1 = acc[ai][bj][m][1] * rs[ai][m];
                        u32x2 w; w.x = pk_bf16(gelu_f(v0[0]) * silu_f(v1[0]), gelu_f(v0[1]) * silu_f(v1[1])); w.y = pk_bf16(gelu_f(v0[2]) * silu_f(v1[2]), gelu_f(v0[3]) * silu_f(v1[3]));
                        *(u32x2*)(rp + bj * (HALF / 2)) = w; } }
        } else {
            bf16_t* dst = GV + (size_t)row0 * 2048 + (colt - 4096) + cl; const int slot = (u.pn - 16) * 4 + wc;
#pragma unroll
            for (int ai = 0; ai < 2; ++ai)
#pragma unroll
                for (int m = 0; m < 4; ++m) { bf16_t* rp = dst + (size_t)(ai * HALF + m * 16) * 2048; float s1 = 0.f, s2 = 0.f;
#pragma unroll
                    for (int bj = 0; bj < 2; ++bj) { f32x4 v0 = acc[ai][bj][m][0] * rs[ai][m], v1 = acc[ai][bj][m][1] * rs[ai][m];
#pragma unroll
                        for (int e = 0; e < 4; ++e) { v0[e] = gelu_f(v0[e]); v1[e] = gelu_f(v1[e]); s1 += v0[e] + v1[e]; s2 += v0[e] * v0[e] + v1[e] * v1[e]; }
                        u32x4 w; w.x = pk_bf16(v0[0], v0[1]); w.y = pk_bf16(v0[2], v0[3]); w.z = pk_bf16(v1[0], v1[1]); w.w = pk_bf16(v1[2], v1[3]);
                        *(u32x4*)(rp + bj * HALF) = w; }
                    s1 += __shfl_xor(s1, 16); s1 += __shfl_xor(s1, 32); s2 += __shfl_xor(s2, 16); s2 += __shfl_xor(s2, 32);
                    if (fq == 0) { float* st = LNST + ((size_t)(row0 + ai * HALF + m * 16) * 32 + slot) * 2; st[0] = s1; st[1] = s2; } }
        }
    }
};
struct EpiPle {
    static constexpr bool PERM = true; static constexpr bool HAS_PRE = false;
    bf16_t* PLE;
    DI void operator()(const f32x4 (&acc)[2][2][4][2], const Unit& u, int wr, int wc, int fr, int fq, LAS unsigned char*, int) const {
        const int row0 = u.pm * BM + wr * 64 + fr, colt = u.pn * BM, cl = wc * 32 + 8 * fq;
        const float rs[2][4] = {{1.f, 1.f, 1.f, 1.f}, {1.f, 1.f, 1.f, 1.f}};
        store_bf16_tile<0>(acc, PLE + (size_t)u.z * MPAD * 1024 + (size_t)row0 * 1024 + colt + cl, 1024, rs);
    }
};
struct EpiRes {
    static constexpr bool PERM = false; static constexpr bool HAS_PRE = false;
    const float* Xin; const bf16_t* HBin; bf16_t* HBo; float* SSPo;
    DI void operator()(const f32x4 (&acc)[2][2][4][2], const Unit& u, int wr, int wc, int fr, int fq, LAS unsigned char*, int) const {
        const int row0 = u.pm * BM + wr * 64 + fr, col0 = u.pn * BM + wc * 32 + 4 * fq;
#pragma unroll
        for (int ai = 0; ai < 2; ++ai)
#pragma unroll
            for (int m = 0; m < 4; ++m) { const int row = row0 + ai * HALF + m * 16; const size_t ro = (size_t)row * 1024 + col0; float ss = 0.f;
#pragma unroll
                for (int bj = 0; bj < 2; ++bj)
#pragma unroll
                    for (int n = 0; n < 2; ++n) { f32x4 h;
                        if (Xin) h = *(const f32x4*)(Xin + ro + bj * HALF + n * 16);
                        else { const u32x2 hb = *(const u32x2*)(HBin + ro + bj * HALF + n * 16); h = (f32x4){bf_lo(hb.x), bf_hi(hb.x), bf_lo(hb.y), bf_hi(hb.y)}; }
                        h += acc[ai][bj][m][n];
                        ss += (h[0] * h[0] + h[1] * h[1]) + (h[2] * h[2] + h[3] * h[3]);
                        u32x2 w; w.x = pk_bf16(h[0], h[1]); w.y = pk_bf16(h[2], h[3]); *(u32x2*)(HBo + ro + bj * HALF + n * 16) = w; }
                ss += __shfl_xor(ss, 16); ss += __shfl_xor(ss, 32);
                if (fq == 0) SSPo[(size_t)row * 16 + u.pn * 4 + wc] = ss;
                if (m & 1) asm volatile("" ::: "memory"); }
    }
};
struct EpiGate {
    static constexpr bool PERM = false; static constexpr bool HAS_PRE = true;
    const bf16_t* HBin; const bf16_t* PLE; const float* SSP; bf16_t* HBo; float* Hout; float* SSPo;
    DI void operator()(const f32x4 (&acc)[2][2][4][2], const Unit& u, int wr, int wc, int fr, int fq, LAS unsigned char* lds, int slot) const {
        const int row0 = u.pm * BM + wr * 64 + fr, col0 = u.pn * BM + wc * 32 + 4 * fq;
        float rs[2][4]; load_rs_lds(lds, slot, wr, fr, rs);
#pragma unroll
        for (int ai = 0; ai < 2; ++ai)
#pragma unroll
            for (int m = 0; m < 4; ++m) { const int row = row0 + ai * HALF + m * 16; const size_t ro = (size_t)row * 1024 + col0; float ss = 0.f;
#pragma unroll
                for (int bj = 0; bj < 2; ++bj)
#pragma unroll
                    for (int n = 0; n < 2; ++n) { const u32x2 hb = *(const u32x2*)(HBin + ro + bj * HALF + n * 16), pl = *(const u32x2*)(PLE + ro + bj * HALF + n * 16);
                        const f32x4 a = acc[ai][bj][m][n] * rs[ai][m]; f32x4 h = (f32x4){bf_lo(hb.x), bf_hi(hb.x), bf_lo(hb.y), bf_hi(hb.y)};
                        h[0] += sigm(a[0]) * bf_lo(pl.x); h[1] += sigm(a[1]) * bf_hi(pl.x); h[2] += sigm(a[2]) * bf_lo(pl.y); h[3] += sigm(a[3]) * bf_hi(pl.y);
                        if (HBo) { ss += (h[0] * h[0] + h[1] * h[1]) + (h[2] * h[2] + h[3] * h[3]);
                            u32x2 w; w.x = pk_bf16(h[0], h[1]); w.y = pk_bf16(h[2], h[3]); *(u32x2*)(HBo + ro + bj * HALF + n * 16) = w; }
                        else *(f32x4*)(Hout + ro + bj * HALF + n * 16) = h; }
                if (HBo) { ss += __shfl_xor(ss, 16); ss += __shfl_xor(ss, 32); if (fq == 0) SSPo[(size_t)row * 16 + u.pn * 4 + wc] = ss; }
                if (m & 1) asm volatile("" ::: "memory"); }
    }
};

template <int K, class Epi>
DI void gemm_phase(LAS unsigned char* lds, const int wid_in, const Gemm g, const Order& S, const Epi& E) {
    int wid = wid_in; asm volatile("" : "+s"(wid));
    const int lane = lane_id_v(), tid = wid * 64 + lane, wr = wid >> 2, wc = wid & 3, fr = lane & 15, fq = lane >> 4;
    constexpr int nt = K / BK;
    unsigned voffA, voffB;
    { int R, C; stage_rc(tid * 16, R, C); const int Rb = Epi::PERM ? ((R & ~31) + perm32(R & 31)) : R;
        voffA = (unsigned)(R * K + C) * 2u; voffB = (unsigned)(Rb * K + C) * 2u; }
    constexpr size_t kstep = (size_t)(BK * 2);
    constexpr size_t hstep = (size_t)HALF * K * 2;
    constexpr size_t tstep = 2 * hstep;
    const unsigned ldsw = (unsigned)wid * 1024u;
    const int aoff = lds_byte(wr * 64 + fr, fq * 8), boff = lds_byte(wc * 32 + fr, fq * 8);
#define PG8_SA(b, h) (((b) * 2 + (h)) * HTB)
#define PG8_SB(b, h) ((4 + (b) * 2 + (h)) * HTB)
#define PG8_STAGE(bufoff, gbase, voff) do { _Pragma("unroll") for (int _i = 0; _i < 2; ++_i) \
        __builtin_amdgcn_global_load_lds((const unsigned*)((const char*)(gbase) + (size_t)_i * (64 * K * 2) + (voff)), (LAS unsigned*)(lds + (bufoff) + ldsw + _i * 8192), 16, 0, 0); } while (0)
#define PG8_LDA(dst, b, h) do { _Pragma("unroll") for (int m = 0; m < 4; ++m) _Pragma("unroll") for (int k = 0; k < 2; ++k) dst[m][k] = *(const LAS bf16x8*)(lds + PG8_SA(b, h) + aoff + m * 2048 + k * 1024); } while (0)
#define PG8_LDB(dst, b, h) do { _Pragma("unroll") for (int n = 0; n < 2; ++n) _Pragma("unroll") for (int k = 0; k < 2; ++k) dst[n][k] = *(const LAS bf16x8*)(lds + PG8_SB(b, h) + boff + n * 2048 + k * 1024); } while (0)
#define PG8_MMA(ai, bj, At, Bt) do { __builtin_amdgcn_s_setprio(1); _Pragma("unroll") for (int m = 0; m < 4; ++m) _Pragma("unroll") for (int n = 0; n < 2; ++n) _Pragma("unroll") for (int k = 0; k < 2; ++k) \
        acc[ai][bj][m][n] = __builtin_amdgcn_mfma_f32_16x16x32_bf16(Bt[n][k], At[m][k], acc[ai][bj][m][n], 0, 0, 0); __builtin_amdgcn_s_setprio(0); } while (0)
#define PG8_WAIT_V(n) asm volatile("s_waitcnt vmcnt(" #n ")" ::: "memory")
#define PG8_WAIT_L(n) asm volatile("s_waitcnt lgkmcnt(" #n ")" ::: "memory")
#define PG8_BAR __builtin_amdgcn_s_barrier()
#define PG8_SCHED __builtin_amdgcn_sched_barrier(0)
    Unit cur, nxt; int ui = 0;
    if (!S.next(0, cur)) return;
    f32x4 acc[2][2][4][2];
#pragma unroll
    for (int a = 0; a < 2; ++a)
#pragma unroll
        for (int b = 0; b < 2; ++b)
#pragma unroll
            for (int m = 0; m < 4; ++m)
#pragma unroll
                for (int n = 0; n < 2; ++n) acc[a][b][m][n] = (f32x4){0.f, 0.f, 0.f, 0.f};
    bf16x8 At[4][2], B0[2][2], B1[2][2];
    const char* cA = (const char*)g.A + (size_t)cur.z * g.Az + (size_t)cur.pm * tstep; const char* cB = (const char*)g.Bt + (size_t)cur.z * g.Bz + (size_t)cur.pn * tstep;
    if constexpr (Epi::HAS_PRE) { const RsPre pf = rs_pre_load(E.SSP, cur.pm, tid); rs_pre_store(lds, pf, 0, tid); }
    PG8_STAGE(PG8_SB(0, 0), cB, voffB); PG8_STAGE(PG8_SB(0, 1), cB + hstep, voffB); PG8_STAGE(PG8_SA(0, 0), cA, voffA); PG8_STAGE(PG8_SA(0, 1), cA + hstep, voffA);
    if (wr == 1) PG8_BAR;
    PG8_WAIT_V(2); PG8_BAR;
    PG8_STAGE(PG8_SB(1, 0), cB + kstep, voffB); PG8_STAGE(PG8_SA(1, 0), cA + kstep, voffA); PG8_STAGE(PG8_SB(1, 1), cB + hstep + kstep, voffB);
    PG8_WAIT_V(6); PG8_BAR;
    for (;;) {
        const bool has_next = S.next(ui + 1, nxt);
        const char* nA = has_next ? (const char*)g.A + (size_t)nxt.z * g.Az + (size_t)nxt.pm * tstep : cA; const char* nB = has_next ? (const char*)g.Bt + (size_t)nxt.z * g.Bz + (size_t)nxt.pn * tstep : cB;
#pragma unroll 1
        for (int t = 0; t < nt; t += 2) {
            const bool last = (t == nt - 2);
            const char* a1 = cA + (size_t)(t + 1) * kstep;
            const char* a2 = last ? nA : cA + (size_t)(t + 2) * kstep; const char* b2 = last ? nB : cB + (size_t)(t + 2) * kstep;
            const char* a3 = a2 + kstep; const char* b3 = b2 + kstep;
            PG8_LDB(B0, 0, 0); PG8_LDB(B1, 0, 1); PG8_SCHED; PG8_LDA(At, 0, 0); PG8_STAGE(PG8_SA(1, 1), a1 + hstep, voffA);
            PG8_WAIT_V(8); PG8_WAIT_L(0); PG8_BAR; PG8_MMA(0, 0, At, B0); PG8_MMA(0, 1, At, B1); PG8_BAR; PG8_SCHED;
            PG8_LDA(At, 0, 1); PG8_STAGE(PG8_SB(0, 0), b2, voffB); PG8_STAGE(PG8_SB(0, 1), b2 + hstep, voffB); PG8_STAGE(PG8_SA(0, 0), a2, voffA);
            PG8_WAIT_V(8); PG8_WAIT_L(0); PG8_BAR; PG8_MMA(1, 0, At, B0); PG8_MMA(1, 1, At, B1); PG8_BAR; PG8_SCHED;
            PG8_LDB(B0, 1, 0); PG8_LDB(B1, 1, 1); PG8_SCHED; PG8_LDA(At, 1, 0); PG8_STAGE(PG8_SA(0, 1), a2 + hstep, voffA);
            PG8_WAIT_V(8); PG8_WAIT_L(0); PG8_BAR; PG8_MMA(0, 0, At, B0); PG8_MMA(0, 1, At, B1); PG8_BAR; PG8_SCHED;
            PG8_LDA(At, 1, 1); PG8_STAGE(PG8_SB(1, 0), b3, voffB); PG8_STAGE(PG8_SB(1, 1), b3 + hstep, voffB); PG8_STAGE(PG8_SA(1, 0), a3, voffA);
            PG8_WAIT_V(8); PG8_WAIT_L(0); PG8_BAR; PG8_MMA(1, 0, At, B0); PG8_MMA(1, 1, At, B1); PG8_BAR; PG8_SCHED;
        }
        if (wr == 0) PG8_BAR;
        if constexpr (Epi::HAS_PRE) {
            RsPre pf; if (has_next) pf = rs_pre_load(E.SSP, nxt.pm, tid);
            E(acc, cur, wr, wc, fr, fq, lds, ui & 1);
            if (has_next) rs_pre_store(lds, pf, (ui + 1) & 1, tid);
        } else E(acc, cur, wr, wc, fr, fq, lds, 0);
        if (!has_next) break;
#pragma unroll
        for (int a = 0; a < 2; ++a)
#pragma unroll
            for (int b = 0; b < 2; ++b)
#pragma unroll
                for (int m = 0; m < 4; ++m)
#pragma unroll
                    for (int n = 0; n < 2; ++n) acc[a][b][m][n] = (f32x4){0.f, 0.f, 0.f, 0.f};
        cur = nxt; cA = nA; cB = nB; ++ui;
        if (wr == 1) PG8_BAR;
    }
    PG8_WAIT_V(0);
    PG8_BAR;
#undef PG8_SA
#undef PG8_SB
#undef PG8_STAGE
#undef PG8_LDA
#undef PG8_LDB
#undef PG8_MMA
#undef PG8_WAIT_V
#undef PG8_WAIT_L
#undef PG8_BAR
#undef PG8_SCHED
}
}


DI float thin_rs(const float* SSS, int row) {
    const f32x4* p = (const f32x4*)(SSS + (size_t)(row - MP) * 64); f32x4 t = p[0];
#pragma unroll
    for (int i = 1; i < 16; ++i) t += p[i];
    return 1.0f / sqrtf(((t[0] + t[1]) + (t[2] + t[3])) * (1.0f / 1024.0f) + EPS);
}
struct TEpiInA { bf16_t* Q; f16_t* LOGF; bf16_t* V; bf16_t* Z; const float* lb; const float* SSS;
    DI float rs_of(int row) const { return thin_rs(SSS, row); }
    DI void operator()(int z, int row, int col, f32x4 v, int lane, float rs) const {
        v *= rs;
        if (col < 1024) { u32x2 o; o.x = pk_bf16(silu_f(v[0]), silu_f(v[1])); o.y = pk_bf16(silu_f(v[2]), silu_f(v[3])); *(u32x2*)(Q + (size_t)row * 1024 + col) = o; }
        else if (col < 2048) { const f32x4 lbv = *(const f32x4*)(lb + col - 1024); f32x4 o;
#pragma unroll
            for (int e = 0; e < 4; ++e) o[e] = __logf(lbv[e] + (1.0f - lbv[e]) * sigm(v[e]));
            u32x2 oh; oh.x = pk_f16(o[0], o[1]); oh.y = pk_f16(o[2], o[3]); *(u32x2*)(LOGF + (size_t)row * 1024 + col - 1024) = oh; }
        else if (col < 4096) { u32x2 o; o.x = pk_bf16(v[0], v[1]); o.y = pk_bf16(v[2], v[3]); *(u32x2*)(V + (size_t)row * 2048 + col - 2048) = o; }
        else { u32x2 o; o.x = pk_bf16(silu_f(v[0]), silu_f(v[1])); o.y = pk_bf16(silu_f(v[2]), silu_f(v[3])); *(u32x2*)(Z + (size_t)row * 2048 + col - 4096) = o; }
    } };
struct TEpiInB { bf16_t* UZ; bf16_t* GV; const float* SSS;
    DI float rs_of(int row) const { return thin_rs(SSS, row); }
    DI void operator()(int z, int row, int col, f32x4 v, int lane, float rs) const {
        v *= rs;
        const bool isz = (col & 4) != 0; f32x4 mine, other;
#pragma unroll
        for (int e = 0; e < 4; ++e) { mine[e] = (col < 4096 && isz) ? silu_f(v[e]) : gelu_f(v[e]); other[e] = __shfl_xor(mine[e], 1); }
        if (col < 4096) { if (!isz) { u32x2 o; o.x = pk_bf16(mine[0] * other[0], mine[1] * other[1]); o.y = pk_bf16(mine[2] * other[2], mine[3] * other[3]); *(u32x2*)(UZ + (size_t)row * 2048 + 4 * (col >> 3)) = o; } }
        else { u32x2 o; o.x = pk_bf16(mine[0], mine[1]); o.y = pk_bf16(mine[2], mine[3]); *(u32x2*)(GV + (size_t)row * 2048 + col - 4096) = o; }
    } };
struct TEpiPle { bf16_t* PLE;
    DI float rs_of(int row) const { return 1.0f; }
    DI void operator()(int z, int row, int col, f32x4 v, int lane, float rs) const { u32x2 o; o.x = pk_bf16(v[0], v[1]); o.y = pk_bf16(v[2], v[3]); *(u32x2*)(PLE + (size_t)z * MPAD * 1024 + (size_t)row * 1024 + col) = o; } };
struct TEpiRes { const float* Xin; const bf16_t* HBin; bf16_t* HBo; float* SSSo;
    DI float rs_of(int row) const { return 1.0f; }
    DI void operator()(int z, int row, int col, f32x4 v, int lane, float rs) const { f32x4 h;
        if (Xin) h = *(const f32x4*)(Xin + (size_t)row * 1024 + col);
        else { const u32x2 hb = *(const u32x2*)(HBin + (size_t)row * 1024 + col); h = (f32x4){bf_lo(hb.x), bf_hi(hb.x), bf_lo(hb.y), bf_hi(hb.y)}; }
        h += v;
        float ss = (h[0] * h[0] + h[1] * h[1]) + (h[2] * h[2] + h[3] * h[3]); ss += __shfl_xor(ss, 1); ss += __shfl_xor(ss, 2);
        if ((lane & 3) == 0) SSSo[(size_t)(row - MP) * 64 + (col >> 4)] = ss;
        u32x2 w; w.x = pk_bf16(h[0], h[1]); w.y = pk_bf16(h[2], h[3]); *(u32x2*)(HBo + (size_t)row * 1024 + col) = w; } };
struct TEpiGate { const bf16_t* HBin; const bf16_t* PLE; const float* SSSi; bf16_t* HBo; float* Hout; float* SSSo;
    DI float rs_of(int row) const { return thin_rs(SSSi, row); }
    DI void operator()(int z, int row, int col, f32x4 v, int lane, float rs) const {
        const u32x2 hb = *(const u32x2*)(HBin + (size_t)row * 1024 + col), pl = *(const u32x2*)(PLE + (size_t)row * 1024 + col);
        f32x4 h = (f32x4){bf_lo(hb.x), bf_hi(hb.x), bf_lo(hb.y), bf_hi(hb.y)};
        v *= rs;
        h[0] += sigm(v[0]) * bf_lo(pl.x); h[1] += sigm(v[1]) * bf_hi(pl.x); h[2] += sigm(v[2]) * bf_lo(pl.y); h[3] += sigm(v[3]) * bf_hi(pl.y);
        if (HBo) { float ss = (h[0] * h[0] + h[1] * h[1]) + (h[2] * h[2] + h[3] * h[3]); ss += __shfl_xor(ss, 1); ss += __shfl_xor(ss, 2);
            if ((lane & 3) == 0) SSSo[(size_t)(row - MP) * 64 + (col >> 4)] = ss;
            u32x2 w; w.x = pk_bf16(h[0], h[1]); w.y = pk_bf16(h[2], h[3]); *(u32x2*)(HBo + (size_t)row * 1024 + col) = w; }
        else *(f32x4*)(Hout + (size_t)row * 1024 + col) = h; } };

template <int K, int NPB, int MT, class Epi>
DI void thin_gemm(LAS unsigned char* lds, const int w, const bf16_t* A  , size_t Az  , const bf16_t* Bt, size_t Bz, const int N, const int nZ,
                  const int bid, const int G, const Epi& E) {
    const int lane = lane_id_v(), tid = w * 64 + lane, fr = lane & 15, fq = lane >> 4;
    constexpr int KW = K / 8, KS = KW / 32;
    constexpr int NMB = 8 / MT;
    LAS float* P = (LAS float*)lds;
    const int npn = N / 16;
    const int ei = tid >> 6, ee = (tid & 63) * 4, er = ee >> 4, ec = ee & 15;
    float rs_row = 1.0f; if (MT == 8) rs_row = E.rs_of(MP + 16 * ei + er);
    for (int p = bid * NPB; p < npn * nZ * NMB; p += G * NPB) {
        const int mblk = p % NMB, pc = p / NMB, z = pc / npn, ng = pc % npn;
        const int mrow = 16 * MT * mblk;
        const bf16_t* a0 = A + (size_t)z * Az + (size_t)(mrow + fr) * K + w * KW + 8 * fq;
        const bf16_t* b0 = Bt + (size_t)z * Bz + (size_t)(16 * ng + fr) * K + w * KW + 8 * fq;
        f32x4 acc[NPB][MT];
#pragma unroll
        for (int q = 0; q < NPB; ++q)
#pragma unroll
            for (int i = 0; i < MT; ++i) acc[q][i] = (f32x4){0.f, 0.f, 0.f, 0.f};
        constexpr int KBM = (NPB > 1 ? 2 : 4) * (8 / MT), KB = KS < KBM ? KS : KBM;
#pragma unroll
        for (int kb = 0; kb < KS; kb += KB) {
            bf16x8 bfr[NPB][KB], afr[KB][MT];
#pragma unroll
            for (int kk = 0; kk < KB; ++kk) {
#pragma unroll
                for (int q = 0; q < NPB; ++q) bfr[q][kk] = *(const bf16x8*)(b0 + (size_t)(16 * q) * K + 32 * (kb + kk));
#pragma unroll
                for (int i = 0; i < MT; ++i) afr[kk][i] = *(const bf16x8*)(a0 + (size_t)(16 * i) * K + 32 * (kb + kk)); }
#pragma unroll
            for (int kk = 0; kk < KB; ++kk)
#pragma unroll
                for (int i = 0; i < MT; ++i)
#pragma unroll
                    for (int q = 0; q < NPB; ++q) acc[q][i] = mfma16(afr[kk][i], bfr[q][kk], acc[q][i]);
        }
        if (MT < 8 && ei < MT) rs_row = E.rs_of(MP + mrow + 16 * ei + er);
#pragma unroll
        for (int q = 0; q < NPB; ++q) {
#pragma unroll
            for (int i = 0; i < MT; ++i)
#pragma unroll
                for (int jj = 0; jj < 4; ++jj) P[(w * MT + i) * 256 + (4 * fq + jj) * 16 + fr] = acc[q][i][jj];
            __syncthreads();
            if (MT == 8 || ei < MT) {
                f32x4 v = (f32x4){0.f, 0.f, 0.f, 0.f};
#pragma unroll
                for (int ww = 0; ww < 8; ++ww) v += *(LAS f32x4*)(P + (ww * MT + ei) * 256 + ee);
                E(z, MP + mrow + 16 * ei + er, 16 * (ng + q) + ec, v, lane, rs_row);
            }
            __syncthreads();
        }
    }
}

DI int uz_row(int n) { return n < 2048 ? 8 * (n >> 2) + (n & 3) : (n < 4096 ? n + 2048 : 8 * ((n - 4096) >> 2) + 4 + (n & 3)); }
template <bool UZMAP = false>
DI void transpose_item(const float* W, int K, int N, bf16_t* WT, LAS float* scr, int item, int lane, const float* kscale = nullptr) {
    const int nblk = N / 32, kb = item / nblk, nb = item % nblk, k0 = 64 * kb, n0 = 32 * nb;
#pragma unroll
    for (int i = 0; i < 8; ++i) { const int kk = 8 * i + (lane >> 3), n4 = (lane & 7) * 4;
        const f32x4 v = *(const f32x4*)(W + (size_t)(k0 + kk) * N + n0 + n4); const float sc = kscale ? kscale[k0 + kk] : 1.0f;
        scr[kk * 33 + n4 + 0] = v[0] * sc; scr[kk * 33 + n4 + 1] = v[1] * sc; scr[kk * 33 + n4 + 2] = v[2] * sc; scr[kk * 33 + n4 + 3] = v[3] * sc; }
    asm volatile("s_waitcnt lgkmcnt(0)" ::: "memory");
    const int c = lane & 7;
#pragma unroll
    for (int j = 0; j < 4; ++j) { const int n = (lane >> 3) + 8 * j; const LAS float* s = scr + (8 * c) * 33 + n;
        u32x4 o; o.x = pk_bf16(s[0 * 33], s[1 * 33]); o.y = pk_bf16(s[2 * 33], s[3 * 33]); o.z = pk_bf16(s[4 * 33], s[5 * 33]); o.w = pk_bf16(s[6 * 33], s[7 * 33]);
        *(u32x4*)(WT + (size_t)(UZMAP ? uz_row(n0 + n) : n0 + n) * K + k0 + 8 * c) = o; }
    asm volatile("s_waitcnt lgkmcnt(0)" ::: "memory");
}

DI void rms_row(const float* src, const float* g, bf16_t* dstb, float* hcopy, float* outf, int lane) {
    f32x4 v[4]; float s = 0.f;
#pragma unroll
    for (int j = 0; j < 4; ++j) { v[j] = src ? ((const f32x4*)src)[lane + 64 * j] : (f32x4){0.f, 0.f, 0.f, 0.f}; s += (v[j][0] * v[j][0] + v[j][1] * v[j][1]) + (v[j][2] * v[j][2] + v[j][3] * v[j][3]); }
    const float rs = 1.0f / sqrtf(wave_sum(s) * (1.0f / 1024.0f) + EPS);
#pragma unroll
    for (int j = 0; j < 4; ++j) { const f32x4 gv = ((const f32x4*)g)[lane + 64 * j]; const f32x4 y = v[j] * rs * gv;
        if (hcopy) ((f32x4*)hcopy)[lane + 64 * j] = v[j];
        if (outf) ((f32x4*)outf)[lane + 64 * j] = y;
        if (dstb) { u32x2 w; w.x = pk_bf16(y[0], y[1]); w.y = pk_bf16(y[2], y[3]); ((u32x2*)dstb)[lane + 64 * j] = w; } }
}

constexpr int SC_QD = 0, SC_KD = 17408, SC_VI = 34816, SC_ATT = 69632, SC_BB = 78848, SC_ER = 112640, SC_EL = 113152, SC_RR = 113664, SC_TOT = 114176, SC_DS = 116224, SC_MISC = 116736;
constexpr int ATT_STRIDE = 144, OT_STRIDE = 528, VIMG = 17408, BBS = 132;
constexpr int NSEG = 4, CPS = (SEQ / 64) / NSEG;

DI bf16x8 tr_frag2(LAS unsigned char* p) {
    const s16x4 a = __builtin_amdgcn_ds_read_tr16_b64_v4i16((LAS s16x4*)p);
    const s16x4 b = __builtin_amdgcn_ds_read_tr16_b64_v4i16((LAS s16x4*)(p + 4 * TS));
    return (bf16x8){a[0], a[1], a[2], a[3], b[0], b[1], b[2], b[3]};
}

template <int MODE>
DI void scan_prompt(LAS unsigned char* lds, const int w, const int bh, const int seg, const bf16_t* Q, const f16_t* LOGF, const bf16_t* V, const bf16_t* Z, bf16_t* A2, const float* gn, float* Sout,
                    float* SL, float* DSEG) {
    const int lane = lane_id_v(), tid = w * 64 + lane, fr = lane & 15, fq = lane >> 4;
    const int b = bh >> 3, h = bh & 7;
    const int lt = tid >> 3, lg = tid & 7;
    const size_t row_base = (size_t)b * SEQ + (size_t)seg * CPS * 64;
    const size_t hm_base = (size_t)bh * SEQ + (size_t)seg * CPS * 64;
    LAS float* BB = (LAS float*)(lds + SC_BB); LAS float* ER = (LAS float*)(lds + SC_ER); LAS float* EL = (LAS float*)(lds + SC_EL); LAS float* RR = (LAS float*)(lds + SC_RR);
    LAS float* TOT = (LAS float*)(lds + SC_TOT); LAS float* DS = (LAS float*)(lds + SC_DS);
    LAS unsigned char* rb16 = lds + fr * TS + fq * 16;
    LAS unsigned char* rb8 = lds + fr * TS + fq * 8;
    LAS unsigned char* trb = lds + (8 * fq + ((lane & 15) >> 2)) * TS + (lane & 3) * 8;
    LAS unsigned char* atb = lds + SC_ATT + fr * ATT_STRIDE + fq * 16;
    f32x4 Sacc[8][2];
#pragma unroll
    for (int mb = 0; mb < 8; ++mb) { Sacc[mb][0] = (f32x4){0.f, 0.f, 0.f, 0.f}; Sacc[mb][1] = (f32x4){0.f, 0.f, 0.f, 0.f}; }
    if (MODE == 0) {
        f32x4 coef[8];
#pragma unroll
        for (int mb = 0; mb < 8; ++mb) coef[mb] = (f32x4){1.f, 1.f, 1.f, 1.f};
        for (int sp = seg - 1; sp >= 0; --sp) {
            const f32x4* sl = (const f32x4*)(SL + ((size_t)bh * (NSEG - 1) + sp) * 128 * 256) + tid;
            f32x4 t[16];
#pragma unroll
            for (int g4 = 0; g4 < 16; ++g4) t[g4] = __builtin_nontemporal_load(sl + (size_t)g4 * 512);
#pragma unroll
            for (int mb = 0; mb < 8; ++mb)
#pragma unroll
                for (int nt = 0; nt < 2; ++nt) Sacc[mb][nt] += coef[mb] * t[mb * 2 + nt];
            if (sp > 0) { const float* dd = DSEG + ((size_t)bh * (NSEG - 1) + sp) * 128;
#pragma unroll
                for (int mb = 0; mb < 8; ++mb) { f32x4 e4 = *(const f32x4*)(dd + 16 * mb + 4 * fq);
                    e4[0] = __expf(e4[0]); e4[1] = __expf(e4[1]); e4[2] = __expf(e4[2]); e4[3] = __expf(e4[3]); coef[mb] *= e4; } }
        }
    } else { if (tid < 128) DS[tid] = 0.f; }
    EL[tid & 127] = 1.0f;
    if (MODE == 0) { if (tid < 256) ((LAS float*)(lds + SC_MISC))[tid] = gn[tid]; }
    u32x4 rq[2]; u32x4 rl[2]; u32x4 rv[4];
    {
        const size_t row = hm_base + lt;
        if (MODE == 0) { const u32x4* qp = (const u32x4*)(Q + row * 128 + 16 * lg); rq[0] = qp[0]; rq[1] = qp[1]; }
        const u32x4* lp = (const u32x4*)(LOGF + row * 128 + 16 * lg);
#pragma unroll
        for (int i = 0; i < 2; ++i) rl[i] = lp[i];
        const u32x4* vp = (const u32x4*)(V + row * 256 + 32 * lg);
#pragma unroll
        for (int i = 0; i < 4; ++i) rv[i] = vp[i];
    }
#pragma unroll 1
    for (int c = 0; c < CPS; ++c) {
        unsigned kkp[8];
#pragma unroll
        for (int i = 0; i < 4; ++i) { const unsigned p0 = rl[i >> 1][2 * (i & 1)], p1 = rl[i >> 1][2 * (i & 1) + 1];
            const f32x4 lf = (f32x4){f16_lo(p0), f16_hi(p0), f16_lo(p1), f16_hi(p1)};
            *(LAS f32x4*)(BB + lt * BBS + 16 * lg + 4 * i) = lf;
            kkp[2 * i] = pk_bf16(1.0f - __expf(lf[0]), 1.0f - __expf(lf[1])); kkp[2 * i + 1] = pk_bf16(1.0f - __expf(lf[2]), 1.0f - __expf(lf[3])); }
#pragma unroll
        for (int i = 0; i < 4; ++i) *(LAS u32x4*)(lds + SC_VI + (lg >> 2) * VIMG + lt * TS + (4 * (lg & 3) + i) * 16) = rv[i];
        __syncthreads();
        {
            const int sg = w >> 1, k = tid & 127; float run[16]; float s = 0.f;
#pragma unroll
            for (int i = 0; i < 16; ++i) { s += BB[(16 * sg + i) * BBS + k]; run[i] = s; }
            TOT[sg * 128 + k] = s;
            __syncthreads();
            const float t0 = TOT[k], t1 = TOT[128 + k], t2 = TOT[256 + k];
            const float off = (sg > 0 ? t0 : 0.f) + (sg > 1 ? t1 : 0.f) + (sg > 2 ? t2 : 0.f);
#pragma unroll
            for (int i = 0; i < 16; ++i) BB[(16 * sg + i) * BBS + k] = run[i] + off;
            if (sg == 3) { const float r = t0 + t1, bl = off + run[15]; RR[k] = r; ER[k] = EL[k] * __expf(r); EL[k] = __expf(bl - r); if (MODE == 1) DS[k] += bl; }
            __syncthreads();
        }
        {
#pragma unroll
            for (int hh = 0; hh < 2; ++hh) {
                const f32x4 b0 = *(LAS f32x4*)(BB + lt * BBS + 16 * lg + 8 * hh), b1 = *(LAS f32x4*)(BB + lt * BBS + 16 * lg + 8 * hh + 4);
                const f32x4 r0 = *(LAS f32x4*)(RR + 16 * lg + 8 * hh), r1 = *(LAS f32x4*)(RR + 16 * lg + 8 * hh + 4);
                const f32x4 d0 = b0 - r0, d1 = b1 - r1;
                u32x4 ko;
                if (MODE == 0) { u32x4 qo;
                    qo.x = pk_bf16(bf_lo(rq[hh].x) * __expf(d0[0]), bf_hi(rq[hh].x) * __expf(d0[1])); qo.y = pk_bf16(bf_lo(rq[hh].y) * __expf(d0[2]), bf_hi(rq[hh].y) * __expf(d0[3]));
                    qo.z = pk_bf16(bf_lo(rq[hh].z) * __expf(d1[0]), bf_hi(rq[hh].z) * __expf(d1[1])); qo.w = pk_bf16(bf_lo(rq[hh].w) * __expf(d1[2]), bf_hi(rq[hh].w) * __expf(d1[3]));
                    *(LAS u32x4*)(lds + SC_QD + lt * TS + (2 * lg + hh) * 16) = qo; }
                ko.x = pk_bf16(bf_lo(kkp[4 * hh]) * __expf(-d0[0]), bf_hi(kkp[4 * hh]) * __expf(-d0[1])); ko.y = pk_bf16(bf_lo(kkp[4 * hh + 1]) * __expf(-d0[2]), bf_hi(kkp[4 * hh + 1]) * __expf(-d0[3]));
                ko.z = pk_bf16(bf_lo(kkp[4 * hh + 2]) * __expf(-d1[0]), bf_hi(kkp[4 * hh + 2]) * __expf(-d1[1])); ko.w = pk_bf16(bf_lo(kkp[4 * hh + 3]) * __expf(-d1[2]), bf_hi(kkp[4 * hh + 3]) * __expf(-d1[3]));
                *(LAS u32x4*)(lds + SC_KD + lt * TS + (2 * lg + hh) * 16) = ko;
            }
        }
        if (MODE == 1) {
        if (c + 1 < CPS) {
            const size_t row = hm_base + (size_t)(c + 1) * 64 + lt;
            if (MODE == 0) { const u32x4* qp = (const u32x4*)(Q + row * 128 + 16 * lg); rq[0] = qp[0]; rq[1] = qp[1]; }
            const u32x4* lp = (const u32x4*)(LOGF + row * 128 + 16 * lg);
#pragma unroll
            for (int i = 0; i < 2; ++i) rl[i] = lp[i];
            const u32x4* vp = (const u32x4*)(V + row * 256 + 32 * lg);
#pragma unroll
            for (int i = 0; i < 4; ++i) rv[i] = vp[i];
        }
        }
        __syncthreads();
        if (MODE == 0) {
            const int mt = w >> 1;
#pragma unroll
            for (int q2 = 0; q2 < 2; ++q2) {
                const int ntp = 2 * (w & 1) + q2;
                f32x4 a4 = (f32x4){0.f, 0.f, 0.f, 0.f};
                if (ntp <= mt) {
#pragma unroll
                    for (int ks = 0; ks < 4; ++ks) {
                        const bf16x8 a = *(LAS bf16x8*)(rb16 + SC_QD + mt * 16 * TS + ks * 64);
                        const bf16x8 bq = *(LAS bf16x8*)(rb16 + SC_KD + ntp * 16 * TS + ks * 64);
                        a4 = mfma16(a, bq, a4);
                    }
                }
#pragma unroll
                for (int jj = 0; jj < 4; ++jj) { const int t = 16 * mt + 4 * fq + jj, s = 16 * ntp + fr; const float val = (s <= t) ? a4[jj] : 0.f;
                    *(LAS bf16_t*)(lds + SC_ATT + t * ATT_STRIDE + s * 2) = (bf16_t)(pk_bf16(val, 0.f) & 0xffffu); }
            }
        }
#pragma unroll
        for (int mb = 0; mb < 8; ++mb) { const f32x4 e4 = *(LAS f32x4*)(ER + 16 * mb + 4 * fq); Sacc[mb][0] *= e4; Sacc[mb][1] *= e4; }
        u32x4 zr[4];
        if (MODE == 0) {
            const u32x4* zp = (const u32x4*)(Z + (hm_base + (size_t)c * 64 + lt) * 256 + 32 * lg);
#pragma unroll
            for (int i = 0; i < 4; ++i) zr[i] = zp[i];
            __syncthreads();
        }
        {
            bf16x8 Vf[2][2];
            LAS unsigned char* vtr = trb + SC_VI + (w >> 2) * VIMG + (w & 3) * 64;
#pragma unroll
            for (int ks = 0; ks < 2; ++ks)
#pragma unroll
                for (int nt = 0; nt < 2; ++nt) Vf[ks][nt] = tr_frag2(vtr + ks * 32 * TS + nt * 32);
            if (MODE == 0) {
                f32x4 Oacc[4][2];
#pragma unroll
                for (int mt = 0; mt < 4; ++mt) { Oacc[mt][0] = (f32x4){0.f, 0.f, 0.f, 0.f}; Oacc[mt][1] = (f32x4){0.f, 0.f, 0.f, 0.f}; }
#pragma unroll
                for (int kb = 0; kb < 4; ++kb) {
                    bf16x8 Bf[2];
#pragma unroll
                    for (int nt = 0; nt < 2; ++nt) { u32x4 p; p.x = pk_bf16(Sacc[2 * kb][nt][0], Sacc[2 * kb][nt][1]); p.y = pk_bf16(Sacc[2 * kb][nt][2], Sacc[2 * kb][nt][3]);
                        p.z = pk_bf16(Sacc[2 * kb + 1][nt][0], Sacc[2 * kb + 1][nt][1]); p.w = pk_bf16(Sacc[2 * kb + 1][nt][2], Sacc[2 * kb + 1][nt][3]); Bf[nt] = __builtin_bit_cast(bf16x8, p); }
#pragma unroll
                    for (int mt = 0; mt < 4; ++mt) {
                        const u32x2 lo = *(LAS u32x2*)(rb8 + SC_QD + mt * 16 * TS + kb * 64);
                        const u32x2 hi = *(LAS u32x2*)(rb8 + SC_QD + mt * 16 * TS + kb * 64 + 32);
                        const bf16x8 a = __builtin_bit_cast(bf16x8, (u32x4){lo.x, lo.y, hi.x, hi.y});
                        Oacc[mt][0] = mfma16(a, Bf[0], Oacc[mt][0]); Oacc[mt][1] = mfma16(a, Bf[1], Oacc[mt][1]);
                    }
                }
#pragma unroll
                for (int ks = 0; ks < 2; ++ks)
#pragma unroll
                    for (int mt = 0; mt < 4; ++mt) {
                        const bf16x8 a = *(LAS bf16x8*)(atb + mt * 16 * ATT_STRIDE + ks * 64);
                        Oacc[mt][0] = mfma16(a, Vf[ks][0], Oacc[mt][0]); Oacc[mt][1] = mfma16(a, Vf[ks][1], Oacc[mt][1]);
                    }
                LAS unsigned char* OT = lds + SC_BB;
#pragma unroll
                for (int mt = 0; mt < 4; ++mt)
#pragma unroll
                    for (int jj = 0; jj < 4; ++jj) { const int t = 16 * mt + 4 * fq + jj;
                        *(LAS bf16_t*)(OT + t * OT_STRIDE + (32 * w + fr) * 2) = (bf16_t)(pk_bf16(Oacc[mt][0][jj], 0.f) & 0xffffu);
                        *(LAS bf16_t*)(OT + t * OT_STRIDE + (32 * w + 16 + fr) * 2) = (bf16_t)(pk_bf16(Oacc[mt][1][jj], 0.f) & 0xffffu); }
            }
#pragma unroll
            for (int mb = 0; mb < 8; ++mb)
#pragma unroll
                for (int ks = 0; ks < 2; ++ks) {
                    const bf16x8 a = tr_frag2(trb + SC_KD + ks * 32 * TS + mb * 32);
                    Sacc[mb][0] = mfma16(a, Vf[ks][0], Sacc[mb][0]); Sacc[mb][1] = mfma16(a, Vf[ks][1], Sacc[mb][1]);
                }
        }
        __syncthreads();
        if (MODE == 0) {
            LAS unsigned char* OT = lds + SC_BB; LAS float* GN = (LAS float*)(lds + SC_MISC);
            u32x4 o8[4]; float ssq = 0.f;
#pragma unroll
            for (int i = 0; i < 4; ++i) { o8[i] = *(LAS u32x4*)(OT + lt * OT_STRIDE + (32 * lg + 8 * i) * 2);
#pragma unroll
                for (int e = 0; e < 4; ++e) { const float a = bf_lo(o8[i][e]), c2 = bf_hi(o8[i][e]); ssq += a * a + c2 * c2; } }
            ssq += __shfl_xor(ssq, 1); ssq += __shfl_xor(ssq, 2); ssq += __shfl_xor(ssq, 4);
            const float rs = 1.0f / sqrtf(ssq * (1.0f / 256.0f) + EPS);
            u32x4* op = (u32x4*)(A2 + (row_base + (size_t)c * 64 + lt) * 2048 + 256 * h + 32 * lg);
#pragma unroll
            for (int i = 0; i < 4; ++i) { const f32x4 g0 = *(LAS f32x4*)(GN + 32 * lg + 8 * i), g1 = *(LAS f32x4*)(GN + 32 * lg + 8 * i + 4); u32x4 r;
                r.x = pk_bf16(bf_lo(o8[i].x) * rs * g0[0] * bf_lo(zr[i].x), bf_hi(o8[i].x) * rs * g0[1] * bf_hi(zr[i].x));
                r.y = pk_bf16(bf_lo(o8[i].y) * rs * g0[2] * bf_lo(zr[i].y), bf_hi(o8[i].y) * rs * g0[3] * bf_hi(zr[i].y));
                r.z = pk_bf16(bf_lo(o8[i].z) * rs * g1[0] * bf_lo(zr[i].z), bf_hi(o8[i].z) * rs * g1[1] * bf_hi(zr[i].z));
                r.w = pk_bf16(bf_lo(o8[i].w) * rs * g1[2] * bf_lo(zr[i].w), bf_hi(o8[i].w) * rs * g1[3] * bf_hi(zr[i].w));
                op[i] = r; }
            if (c + 1 < CPS) {
                const size_t row = hm_base + (size_t)(c + 1) * 64 + lt;
                if (MODE == 0) { const u32x4* qp = (const u32x4*)(Q + row * 128 + 16 * lg); rq[0] = qp[0]; rq[1] = qp[1]; }
                const u32x4* lp = (const u32x4*)(LOGF + row * 128 + 16 * lg);
#pragma unroll
                for (int i = 0; i < 2; ++i) rl[i] = lp[i];
                const u32x4* vp = (const u32x4*)(V + row * 256 + 32 * lg);
#pragma unroll
                for (int i = 0; i < 4; ++i) rv[i] = vp[i];
            }
            __syncthreads();
        }
    }
#pragma unroll
    for (int mb = 0; mb < 8; ++mb) { const f32x4 e4 = *(LAS f32x4*)(EL + 16 * mb + 4 * fq); Sacc[mb][0] *= e4; Sacc[mb][1] *= e4; }
    if (MODE == 1) {
        f32x4* sl = (f32x4*)(SL + ((size_t)bh * (NSEG - 1) + seg) * 128 * 256) + tid;
#pragma unroll
        for (int mb = 0; mb < 8; ++mb)
#pragma unroll
            for (int nt = 0; nt < 2; ++nt) sl[(size_t)(mb * 2 + nt) * 512] = Sacc[mb][nt];
        if (tid < 128) DSEG[((size_t)bh * (NSEG - 1) + seg) * 128 + tid] = DS[tid];
        __syncthreads();
    } else if (seg == NSEG - 1) {
        float* so = Sout + (size_t)bh * 128 * 256;
#pragma unroll
        for (int mb = 0; mb < 8; ++mb)
#pragma unroll
            for (int nt = 0; nt < 2; ++nt)
#pragma unroll
                for (int jj = 0; jj < 4; ++jj) so[(size_t)(16 * mb + 4 * fq + jj) * 256 + 32 * w + 16 * nt + fr] = Sacc[mb][nt][jj];
    }
    if (MODE == 0) __syncthreads();
}

DI void scan_sample(LAS unsigned char* lds, const int w, int item, const bf16_t* Q, const f16_t* LOGF, const bf16_t* V, const bf16_t* Z, bf16_t* A2, const float* gn, const float* S0, float* S1) {
    const int lane = lane_id_v(), tid = w * 64 + lane;
    const int b = item >> 3, h = item & 7; const size_t row = (size_t)MP + b;
    LAS float* F = (LAS float*)lds; LAS float* KK = F + 128; LAS float* QQ = F + 256; LAS float* RED = F + 384; LAS float* WS4 = F + 384 + 2048;
    const float* s0 = S0 + (size_t)(b * 8 + h) * 128 * 256; float* s1 = S1 + (size_t)(b * 8 + h) * 128 * 256;
    f32x4 sv[16];
#pragma unroll
    for (int i = 0; i < 16; ++i) sv[i] = __builtin_nontemporal_load((const f32x4*)(s0 + (size_t)(w + 8 * i) * 256) + lane);
    if (tid < 128) { const float lf = (float)__builtin_bit_cast(_Float16, LOGF[row * 1024 + 128 * h + tid]); const float f = __expf(lf); F[tid] = f; KK[tid] = 1.0f - f; QQ[tid] = bf_lo((unsigned)Q[row * 1024 + 128 * h + tid]); }
    const u32x2 vv = *(const u32x2*)(V + row * 2048 + 256 * h + 4 * lane);
    const f32x4 v4 = (f32x4){bf_lo(vv.x), bf_hi(vv.x), bf_lo(vv.y), bf_hi(vv.y)};
    __syncthreads();
    f32x4 o = (f32x4){0.f, 0.f, 0.f, 0.f};
#pragma unroll
    for (int i = 0; i < 16; ++i) { const int k = w + 8 * i; const f32x4 sn = sv[i] * F[k] + v4 * KK[k]; o += sn * QQ[k];
        __builtin_nontemporal_store(sn, (f32x4*)(s1 + (size_t)k * 256) + lane); }
    *(LAS f32x4*)(RED + w * 256 + 4 * lane) = o;
    __syncthreads();
    if (tid < 256) { float s = 0.f;
#pragma unroll
        for (int i = 0; i < 8; ++i) s += RED[i * 256 + tid];
        const float p = wave_sum(s * s); if (lane == 0) WS4[w] = p;
        RED[tid] = s; }
    __syncthreads();
    if (tid < 256) { const float ss = WS4[0] + WS4[1] + WS4[2] + WS4[3]; const float rs = 1.0f / sqrtf(ss * (1.0f / 256.0f) + EPS);
        const float zz = bf_lo((unsigned)Z[row * 2048 + 256 * h + tid]);
        A2[row * 2048 + 256 * h + tid] = (bf16_t)(pk_bf16(RED[tid] * rs * gn[tid] * zz, 0.f) & 0xffffu); }
    __syncthreads();
}

DI void ln_row(bf16_t* gv, const float* g, const float* bta, float* outf, int lane) {
    u32x4 x[4]; float s = 0.f;
#pragma unroll
    for (int i = 0; i < 4; ++i) { x[i] = ((const u32x4*)gv)[lane + 64 * i];
#pragma unroll
        for (int e = 0; e < 4; ++e) s += bf_lo(x[i][e]) + bf_hi(x[i][e]); }
    const float mu = wave_sum(s) * (1.0f / 2048.0f); float q = 0.f;
#pragma unroll
    for (int i = 0; i < 4; ++i)
#pragma unroll
        for (int e = 0; e < 4; ++e) { const float a = bf_lo(x[i][e]) - mu, c = bf_hi(x[i][e]) - mu; q += a * a + c * c; }
    const float rstd = 1.0f / sqrtf(wave_sum(q) * (1.0f / 2048.0f) + EPS);
#pragma unroll
    for (int i = 0; i < 4; ++i) { const int c0 = 8 * (lane + 64 * i);
        const f32x4 g0 = *(const f32x4*)(g + c0), g1 = *(const f32x4*)(g + c0 + 4), b0 = *(const f32x4*)(bta + c0), b1 = *(const f32x4*)(bta + c0 + 4);
        f32x4 y0, y1;
        y0[0] = (bf_lo(x[i][0]) - mu) * rstd * g0[0] + b0[0]; y0[1] = (bf_hi(x[i][0]) - mu) * rstd * g0[1] + b0[1];
        y0[2] = (bf_lo(x[i][1]) - mu) * rstd * g0[2] + b0[2]; y0[3] = (bf_hi(x[i][1]) - mu) * rstd * g0[3] + b0[3];
        y1[0] = (bf_lo(x[i][2]) - mu) * rstd * g1[0] + b1[0]; y1[1] = (bf_hi(x[i][2]) - mu) * rstd * g1[1] + b1[1];
        y1[2] = (bf_lo(x[i][3]) - mu) * rstd * g1[2] + b1[2]; y1[3] = (bf_hi(x[i][3]) - mu) * rstd * g1[3] + b1[3];
        u32x4 o; o.x = pk_bf16(y0[0], y0[1]); o.y = pk_bf16(y0[2], y0[3]); o.z = pk_bf16(y1[0], y1[1]); o.w = pk_bf16(y1[2], y1[3]);
        ((u32x4*)gv)[lane + 64 * i] = o;
        if (outf) { *(f32x4*)(outf + c0) = y0; *(f32x4*)(outf + c0 + 4) = y1; } }
}

DI void ln_gate_sample_row(const bf16_t* gv, const bf16_t* uzrow, bf16_t* a2row, const float* g, const float* bta, const float* wsp, const float* bsp, float* outf, int lane) {
    u32x4 x[4]; float s = 0.f;
#pragma unroll
    for (int i = 0; i < 4; ++i) { x[i] = ((const u32x4*)gv)[lane + 64 * i];
#pragma unroll
        for (int e = 0; e < 4; ++e) s += bf_lo(x[i][e]) + bf_hi(x[i][e]); }
    const float mu = wave_sum(s) * (1.0f / 2048.0f); float q = 0.f;
#pragma unroll
    for (int i = 0; i < 4; ++i)
#pragma unroll
        for (int e = 0; e < 4; ++e) { const float a = bf_lo(x[i][e]) - mu, c = bf_hi(x[i][e]) - mu; q += a * a + c * c; }
    const float rstd = 1.0f / sqrtf(wave_sum(q) * (1.0f / 2048.0f) + EPS);
#pragma unroll
    for (int i = 0; i < 4; ++i) { const int c0 = 8 * (lane + 64 * i), grp = c0 >> 8; const float w00 = wsp[(size_t)grp * 128 * 128], b0s = bsp[grp * 128];
        const f32x4 g0 = *(const f32x4*)(g + c0), g1 = *(const f32x4*)(g + c0 + 4), b0 = *(const f32x4*)(bta + c0), b1 = *(const f32x4*)(bta + c0 + 4);
        f32x4 y0, y1;
        y0[0] = (bf_lo(x[i][0]) - mu) * rstd * g0[0] + b0[0]; y0[1] = (bf_hi(x[i][0]) - mu) * rstd * g0[1] + b0[1];
        y0[2] = (bf_lo(x[i][1]) - mu) * rstd * g0[2] + b0[2]; y0[3] = (bf_hi(x[i][1]) - mu) * rstd * g0[3] + b0[3];
        y1[0] = (bf_lo(x[i][2]) - mu) * rstd * g1[0] + b1[0]; y1[1] = (bf_hi(x[i][2]) - mu) * rstd * g1[1] + b1[1];
        y1[2] = (bf_lo(x[i][3]) - mu) * rstd * g1[2] + b1[2]; y1[3] = (bf_hi(x[i][3]) - mu) * rstd * g1[3] + b1[3];
        *(f32x4*)(outf + c0) = y0; *(f32x4*)(outf + c0 + 4) = y1;
        const u32x4 uz = *(const u32x4*)(uzrow + c0); u32x4 o;
        o.x = pk_bf16(bf_lo(uz.x) * (w00 * y0[0] + b0s), bf_hi(uz.x) * (w00 * y0[1] + b0s));
        o.y = pk_bf16(bf_lo(uz.y) * (w00 * y0[2] + b0s), bf_hi(uz.y) * (w00 * y0[3] + b0s));
        o.z = pk_bf16(bf_lo(uz.z) * (w00 * y1[0] + b0s), bf_hi(uz.z) * (w00 * y1[1] + b0s));
        o.w = pk_bf16(bf_lo(uz.w) * (w00 * y1[2] + b0s), bf_hi(uz.w) * (w00 * y1[3] + b0s));
        *(u32x4*)(a2row + c0) = o; }
}

constexpr int SP_WI = 0, SP_VI = 34816, SP_VIMG = 34816, SP_MU = 106496;
DI void spatial_item(LAS unsigned char* lds, const int w, int item, const float* Wsp, const float* bsp, const bf16_t* VN, const bf16_t* UZ, bf16_t* A2,
                     const float* LNST, const float* lng, const float* lnb, float* cvp  ) {
    const int lane = lane_id_v(), tid = w * 64 + lane, fr = lane & 15, fq = lane >> 4;
    const int g = item & 7, n = (item >> 3) & 15, b = item >> 7;
    const size_t row_base = (size_t)b * SEQ + (size_t)n * 128;
    LAS float* MU = (LAS float*)(lds + SP_MU);
    if (tid < 128) {
        const f32x4* p = (const f32x4*)(LNST + (row_base + tid) * 64); f32x4 t = p[0];
#pragma unroll
        for (int i = 1; i < 16; ++i) t += p[i];
        const float mu = (t[0] + t[2]) * (1.0f / 2048.0f), var = fmaxf((t[1] + t[3]) * (1.0f / 2048.0f) - mu * mu, 0.f);
        MU[tid] = mu; MU[128 + tid] = 1.0f / sqrtf(var + EPS);
    }
    __syncthreads();
    {
        const float* wg = Wsp + (size_t)g * 128 * 128;
#pragma unroll
        for (int i = 0; i < 4; ++i) { const int ci = tid + 512 * i, t = ci >> 4, ch = ci & 15;
            const f32x4 a = *(const f32x4*)(wg + t * 128 + 8 * ch), c = *(const f32x4*)(wg + t * 128 + 8 * ch + 4); const int s0 = 8 * ch;
            u32x4 o; o.x = pk_bf16(s0 + 0 <= t ? a[0] : 0.f, s0 + 1 <= t ? a[1] : 0.f); o.y = pk_bf16(s0 + 2 <= t ? a[2] : 0.f, s0 + 3 <= t ? a[3] : 0.f);
            o.z = pk_bf16(s0 + 4 <= t ? c[0] : 0.f, s0 + 5 <= t ? c[1] : 0.f); o.w = pk_bf16(s0 + 6 <= t ? c[2] : 0.f, s0 + 7 <= t ? c[3] : 0.f);
            *(LAS u32x4*)(lds + SP_WI + t * TS + ch * 16) = o; }
        const int c32 = tid & 31, cc = 256 * g + 8 * c32;
        const f32x4 g0 = *(const f32x4*)(lng + cc), g1 = *(const f32x4*)(lng + cc + 4), b0 = *(const f32x4*)(lnb + cc), b1 = *(const f32x4*)(lnb + cc + 4);
#pragma unroll
        for (int i = 0; i < 8; ++i) { const int s = (tid >> 5) + 16 * i;
            const u32x4 x = *(const u32x4*)(VN + (row_base + s) * 2048 + cc);
            const float mu = MU[s], rstd = MU[128 + s]; f32x4 y0, y1;
            y0[0] = (bf_lo(x.x) - mu) * rstd * g0[0] + b0[0]; y0[1] = (bf_hi(x.x) - mu) * rstd * g0[1] + b0[1]; y0[2] = (bf_lo(x.y) - mu) * rstd * g0[2] + b0[2]; y0[3] = (bf_hi(x.y) - mu) * rstd * g0[3] + b0[3];
            y1[0] = (bf_lo(x.z) - mu) * rstd * g1[0] + b1[0]; y1[1] = (bf_hi(x.z) - mu) * rstd * g1[1] + b1[1]; y1[2] = (bf_lo(x.w) - mu) * rstd * g1[2] + b1[2]; y1[3] = (bf_hi(x.w) - mu) * rstd * g1[3] + b1[3];
            if (n == 15) { float* o = cvp + ((size_t)b * 128 + s) * 2048 + cc; *(f32x4*)o = y0; *(f32x4*)(o + 4) = y1; }
            u32x4 o; o.x = pk_bf16(y0[0], y0[1]); o.y = pk_bf16(y0[2], y0[3]); o.z = pk_bf16(y1[0], y1[1]); o.w = pk_bf16(y1[2], y1[3]);
            *(LAS u32x4*)(lds + SP_VI + (c32 >> 4) * SP_VIMG + s * TS + (c32 & 15) * 16) = o; }
    }
    __syncthreads();
    f32x4 acc[8][2];
#pragma unroll
    for (int mt = 0; mt < 8; ++mt) { acc[mt][0] = (f32x4){0.f, 0.f, 0.f, 0.f}; acc[mt][1] = (f32x4){0.f, 0.f, 0.f, 0.f}; }
    LAS unsigned char* vtr = lds + SP_VI + (w >> 2) * SP_VIMG + (w & 3) * 64 + (8 * fq + ((lane & 15) >> 2)) * TS + (lane & 3) * 8;
    LAS unsigned char* wrb = lds + SP_WI + fr * TS + fq * 16;
#pragma unroll
    for (int ks = 0; ks < 4; ++ks) {
        const bf16x8 v0 = tr_frag2(vtr + ks * 32 * TS), v1 = tr_frag2(vtr + ks * 32 * TS + 32);
#pragma unroll
        for (int mt = 0; mt < 8; ++mt) {
            if (32 * ks > 16 * mt + 15) continue;
            const bf16x8 wf = *(LAS bf16x8*)(wrb + mt * 16 * TS + ks * 64);
            acc[mt][0] = mfma16(v0, wf, acc[mt][0]); acc[mt][1] = mfma16(v1, wf, acc[mt][1]);
        }
    }
    __syncthreads();
    {
        constexpr int SS = 528;
        const float* bg = bsp + g * 128;
#pragma unroll
        for (int mt = 0; mt < 8; ++mt) { const int t = 16 * mt + fr; const float bs = bg[t];
#pragma unroll
            for (int nt = 0; nt < 2; ++nt) { const f32x4 a = acc[mt][nt]; u32x2 o; o.x = pk_bf16(a[0] + bs, a[1] + bs); o.y = pk_bf16(a[2] + bs, a[3] + bs);
                *(LAS u32x2*)(lds + t * SS + (32 * w + 16 * nt + 4 * fq) * 2) = o; } }
        __syncthreads();
#pragma unroll
        for (int i = 0; i < 2; ++i) { const int task = tid + 512 * i, t = task >> 3, cg8 = task & 7;
            const size_t ro = (row_base + t) * 2048 + 256 * g + 32 * cg8;
            const u32x4* up = (const u32x4*)(UZ + ro); u32x4* op = (u32x4*)(A2 + ro);
#pragma unroll
            for (int q = 0; q < 4; ++q) { const u32x4 sv = *(LAS u32x4*)(lds + t * SS + (32 * cg8 + 8 * q) * 2); const u32x4 uu = up[q]; u32x4 o;
#pragma unroll
                for (int e = 0; e < 4; ++e) o[e] = pk_bf16(bf_lo(uu[e]) * bf_lo(sv[e]), bf_hi(uu[e]) * bf_hi(sv[e]));
                op[q] = o; } }
    }
    __syncthreads();
}

#define XB_TMO      128
#define XB_XCNT(j)  (256  + 64 * (j))
#define XB_XSUB(j)  (1280 + 64 * (j))
#define XB_XGEN(j)  (2304 + 64 * (j))
#define XB_TOP      3328
#define XB_TOPGEN   3392
#define XCD_BAR_WORDS 3456
#define XB_SPIN_CAP (1u << 18)
DI unsigned xb_ld(unsigned* p)              { return __hip_atomic_load(p, __ATOMIC_RELAXED, __HIP_MEMORY_SCOPE_AGENT); }
DI unsigned xb_add(unsigned* p, unsigned v) { return __hip_atomic_fetch_add(p, v, __ATOMIC_RELAXED, __HIP_MEMORY_SCOPE_AGENT); }
DI unsigned xb_xcc_id() { return (unsigned)__builtin_amdgcn_s_getreg((3 << 11) | 20) & 0xFu; }
#define XB_SPIN(cond, bar) do { unsigned _sp = 0; while (cond) { __builtin_amdgcn_s_sleep(1); \
    if ((++_sp & 255u) == 0u) { if (xb_ld(&(bar)[XB_TMO])) break; if (_sp > XB_SPIN_CAP) { atomicAdd(&(bar)[XB_TMO], 1u); break; } } } } while (0)
struct XcdBarrier { unsigned* bar; unsigned x; volatile LAS unsigned* st; };
DI XcdBarrier xcd_barrier_post(unsigned* bar, volatile LAS unsigned* st, bool leader) {
    XcdBarrier b; b.bar = bar; b.x = xb_xcc_id(); b.st = st;
    if (leader) (void)xb_add(&bar[XB_XCNT(b.x)], 1u);
    return b;
}
DI void xcd_barrier_complete(unsigned* bar, unsigned x, unsigned& nloc, unsigned& nx) {
    const unsigned G = gridDim.x * gridDim.y * gridDim.z;
    unsigned sum, cnt, mine, sp = 0u;
    for (;;) {
        sum = 0u; cnt = 0u; mine = 0u;
#pragma unroll
        for (unsigned j = 0; j < 16; ++j) { const unsigned c = xb_ld(&bar[XB_XCNT(j)]); sum += c; cnt += (c > 0u) ? 1u : 0u; mine = (j == x) ? c : mine; }
        if (sum == G) break;
        __builtin_amdgcn_s_sleep(1);
        if ((++sp & 255u) == 0u) { if (xb_ld(&bar[XB_TMO])) break; if (sp > XB_SPIN_CAP) { atomicAdd(&bar[XB_TMO], 1u); break; } }
    }
    nloc = mine > 0u ? mine : 1u; nx = cnt > 0u ? cnt : 1u;
}
DI void xcd_barrier(const XcdBarrier& b, const int wave) {
    asm volatile("s_waitcnt vmcnt(0)" ::: "memory");
    __syncthreads();
    if (wave == 0 && lane_id_v() == 0) {
        unsigned* bar = b.bar;
        __builtin_amdgcn_s_waitcnt(0);
        unsigned nloc = b.st[0], nx = b.st[1];
        if (nloc == 0u) { xcd_barrier_complete(bar, b.x, nloc, nx); b.st[0] = nloc; b.st[1] = nx; }
        const unsigned old = xb_add(&bar[XB_XSUB(b.x)], 1u);
        const unsigned gen = old / nloc;
        if (old + 1u == (gen + 1u) * nloc) {
            __builtin_amdgcn_fence(__ATOMIC_RELEASE, "agent");
            asm volatile("s_waitcnt vmcnt(0)" ::: "memory");
            const unsigned og = xb_add(&bar[XB_TOP], 1u);
            const unsigned tg = og / nx;
            if (og + 1u == (tg + 1u) * nx) xb_add(&bar[XB_TOPGEN], 1u);
            else XB_SPIN(xb_ld(&bar[XB_TOPGEN]) == tg, bar);
            __builtin_amdgcn_fence(__ATOMIC_ACQUIRE, "agent");
            xb_add(&bar[XB_XGEN(b.x)], 1u);
            asm volatile("s_waitcnt vmcnt(0)" ::: "memory");
        } else {
            XB_SPIN(xb_ld(&bar[XB_XGEN(b.x)]) == gen, bar);
            __builtin_amdgcn_fence(__ATOMIC_ACQUIRE, "agent");
            asm volatile("s_waitcnt vmcnt(0)" ::: "memory");
        }
    }
    __syncthreads();
}

struct Args { const float* in[20]; float* out; unsigned char* ws; int ph_lo, ph_hi; };
constexpr int N_PHASES = 2 + (4 + 4 + 5 + 4) + 1;
#define WSP(T, off) ((T*)(A->ws + (off)))
typedef const __attribute__((address_space(4))) Args KArgs;
DI KArgs* ka_ptr() { KArgs* p = (KArgs*)__builtin_amdgcn_kernarg_segment_ptr(); asm volatile("" : "+s"(p)); return p; }

__global__ void __launch_bounds__(NTHREADS, 2) fwd_kernel(Args args) {
    extern __shared__ __attribute__((aligned(16))) unsigned char lds_raw[];
    LAS unsigned char* lds = (LAS unsigned char*)lds_raw;
    const int wave = __builtin_amdgcn_readfirstlane(threadIdx.x >> 6);
    const int G = gridDim.x, bid = blockIdx.x;
    const int gw = bid * NWAVES + wave, NGW = G * NWAVES;
    const int lo = args.ph_lo, hi = args.ph_hi;

    volatile LAS unsigned* xst = (volatile LAS unsigned*)(lds + LDS_BYTES - 64);
    if (threadIdx.x < 2) xst[threadIdx.x] = 0u;
    __syncthreads();
    (void)xcd_barrier_post((unsigned*)(args.ws + WS_CTR), xst, threadIdx.x == 0);

    int ph = 0;
#define RUN_PHASE (lo <= ph && ph < hi)
#define SEAM() do { if (lo <= ph && ph + 1 < hi) { if (ka_ptr()->ph_lo < 0) cg::this_grid().sync(); else { XcdBarrier xb_; xb_.bar = (unsigned*)(ka_ptr()->ws + WS_CTR); xb_.x = xb_xcc_id(); xb_.st = (volatile LAS unsigned*)(lds + LDS_BYTES - 64); xcd_barrier(xb_, wave); } } ++ph; } while (0)

    if (RUN_PHASE) { KArgs* A = ka_ptr();
        const int lane = lane_id_v();
        LAS float* scr = (LAS float*)(lds + wave * 16384);
        constexpr int I_IN = 16 * 192, I_OUT = 32 * 32, I_G = 16 * 32, I_P = 4 * 32;
        constexpr int NITEMS = 4 * I_IN + 4 * I_OUT + 4 * I_G + 4 * I_P;
        for (int it = gw; it < NITEMS; it += NGW) {
            int r = it;
            if (r < 2 * I_IN) { const int j = r / I_IN; transpose_item(A->in[6] + (size_t)j * 1024 * 6144, 1024, 6144, WSP(bf16_t, WS_WINA) + (size_t)j * 6144 * 1024, scr, r % I_IN, lane, A->in[5] + (2 * j) * 1024); continue; } r -= 2 * I_IN;
            if (r < 2 * I_IN) { const int j = r / I_IN; transpose_item<true>(A->in[10] + (size_t)j * 1024 * 6144, 1024, 6144, WSP(bf16_t, WS_WINB) + (size_t)j * 6144 * 1024, scr, r % I_IN, lane, A->in[5] + (2 * j + 1) * 1024); continue; } r -= 2 * I_IN;
            if (r < 2 * I_OUT) { const int j = r / I_OUT; transpose_item(A->in[9] + (size_t)j * 2048 * 1024, 2048, 1024, WSP(bf16_t, WS_WOUTA) + (size_t)j * 1024 * 2048, scr, r % I_OUT, lane); continue; } r -= 2 * I_OUT;
            if (r < 2 * I_OUT) { const int j = r / I_OUT; transpose_item(A->in[15] + (size_t)j * 2048 * 1024, 2048, 1024, WSP(bf16_t, WS_WOUTB) + (size_t)j * 1024 * 2048, scr, r % I_OUT, lane); continue; } r -= 2 * I_OUT;
            if (r < 4 * I_G) { const int j = r / I_G; transpose_item(A->in[17] + (size_t)j * 1024 * 1024, 1024, 1024, WSP(bf16_t, WS_WG) + (size_t)j * 1024 * 1024, scr, r % I_G, lane, A->in[16] + j * 1024); continue; } r -= 4 * I_G;
            { const int j = r / I_P; transpose_item(A->in[18] + (size_t)j * 256 * 1024, 256, 1024, WSP(bf16_t, WS_WP) + (size_t)j * 1024 * 256, scr, r % I_P, lane); }
        }
        for (int m = gw; m < MR; m += NGW) {
            const float* src = m < MP ? A->in[0] + (size_t)m * 1024 : A->in[1] + (size_t)(m - MP) * 1024;
            float ss = 0.f;
#pragma unroll
            for (int jq = 0; jq < 4; ++jq) { const f32x4 v = ((const f32x4*)src)[lane + 64 * jq]; ss += (v[0] * v[0] + v[1] * v[1]) + (v[2] * v[2] + v[3] * v[3]);
                u32x2 w; w.x = pk_bf16(v[0], v[1]); w.y = pk_bf16(v[2], v[3]); ((u32x2*)(WSP(bf16_t, WS_HB) + (size_t)m * 1024))[lane + 64 * jq] = w; }
            ss = wave_sum(ss);
            const float one = (lane == 0) ? ss : 0.f;
            if (m < MP) { if (lane < 16) WSP(float, WS_SSPB)[(size_t)m * 16 + lane] = one; }
            else WSP(float, WS_SSSB)[(size_t)(m - MP) * 64 + lane] = one;
        }
        for (int idx = gw; idx < 4 * MPAD; idx += NGW) {
            const int i = idx / MPAD, m = idx % MPAD;
            f32x4 v = (f32x4){0.f, 0.f, 0.f, 0.f};
            if (m < MP) v = ((const f32x4*)(A->in[3] + ((size_t)i * MP + m) * 256))[lane];
            else if (m < MR) v = ((const f32x4*)(A->in[4] + ((size_t)i * NSMP + (m - MP)) * 256))[lane];
            u32x2 o; o.x = pk_bf16(v[0], v[1]); o.y = pk_bf16(v[2], v[3]);
            ((u32x2*)(WSP(bf16_t, WS_PB) + (size_t)idx * 256))[lane] = o;
        }
        if (bid == 0) { const float* lb_logits = A->in[7]; float* LB = WSP(float, WS_LB);
            for (int c = wave * 64 + lane; c < 1024; c += NTHREADS) {
                const float l0 = lb_logits[c], l1 = lb_logits[1024 + c], mx = fmaxf(l0, l1), e0 = expf(l0 - mx), e1 = expf(l1 - mx), s0 = e0 / (e0 + e1), s1 = e1 / (e0 + e1);
                const float c0 = s0, c1 = s0 + s1; LB[c] = c0 - c0; LB[1024 + c] = c1 - c0; } }
    }
    SEAM();
    if (RUN_PHASE) { KArgs* A = ka_ptr();
        { pg8::Gemm g{WSP(bf16_t, WS_PB), WSP(bf16_t, WS_WP), (size_t)MPAD * 256 * 2, (size_t)1024 * 256 * 2}; pg8::Order S; S.init(MP, 1024, 4, G, bid); pg8::EpiPle E{WSP(bf16_t, WS_PLE)}; pg8::gemm_phase<256>(lds, wave, g, S, E);
          TEpiPle TE{WSP(bf16_t, WS_PLE)}; thin_gemm<256, 1, 8>(lds, wave, WSP(bf16_t, WS_PB) + (size_t)MP * 256, (size_t)MPAD * 256, WSP(bf16_t, WS_WP), (size_t)1024 * 256, 1024, 4, bid, G, TE); }
        { pg8::Gemm g{WSP(bf16_t, WS_HB), WSP(bf16_t, WS_WINA), 0, 0}; pg8::Order S; S.init(MP, 6144, 1, G, bid);
          pg8::EpiInA E{WSP(bf16_t, WS_Q), WSP(f16_t, WS_LOGF), WSP(bf16_t, WS_V), WSP(bf16_t, WS_Z), WSP(float, WS_LB), WSP(float, WS_SSPB)}; pg8::gemm_phase<1024>(lds, wave, g, S, E);
          TEpiInA TE{WSP(bf16_t, WS_Q), WSP(f16_t, WS_LOGF), WSP(bf16_t, WS_V), WSP(bf16_t, WS_Z), WSP(float, WS_LB), WSP(float, WS_SSSB)}; thin_gemm<1024, 2, 8>(lds, wave, WSP(bf16_t, WS_HB) + (size_t)MP * 1024, 0, WSP(bf16_t, WS_WINA), 0, 6144, 1, bid, G, TE); }
    }
    SEAM();
#pragma unroll 1
    for (int li = 0; li < 4; ++li) {
        const int j = li >> 1;
        if ((li & 1) == 0) {
            if (li > 0) {
                if (RUN_PHASE) { KArgs* A = ka_ptr(); pg8::Gemm g{WSP(bf16_t, WS_HB), WSP(bf16_t, WS_WINA) + (size_t)j * 6144 * 1024, 0, 0}; pg8::Order S; S.init(MP, 6144, 1, G, bid);
                    pg8::EpiInA E{WSP(bf16_t, WS_Q), WSP(f16_t, WS_LOGF), WSP(bf16_t, WS_V), WSP(bf16_t, WS_Z), WSP(float, WS_LB) + j * 1024, WSP(float, WS_SSPB)}; pg8::gemm_phase<1024>(lds, wave, g, S, E);
                    TEpiInA TE{WSP(bf16_t, WS_Q), WSP(f16_t, WS_LOGF), WSP(bf16_t, WS_V), WSP(bf16_t, WS_Z), WSP(float, WS_LB) + j * 1024, WSP(float, WS_SSSB)}; thin_gemm<1024, 2, 8>(lds, wave, WSP(bf16_t, WS_HB) + (size_t)MP * 1024, 0, WSP(bf16_t, WS_WINA) + (size_t)j * 6144 * 1024, 0, 6144, 1, bid, G, TE); }
                SEAM();
            }
            if (RUN_PHASE) { KArgs* A = ka_ptr();
                const float* gn = A->in[8] + j * 256;
                const float* s0 = A->in[2] + (size_t)j * 128 * 8 * 128 * 256; float* s1 = A->out + OUT_SS + (size_t)j * 128 * 8 * 128 * 256;
                const bf16_t* Qb = WSP(bf16_t, WS_Q); const f16_t* LOGF = WSP(f16_t, WS_LOGF); const bf16_t* Vb = WSP(bf16_t, WS_V); const bf16_t* Zb = WSP(bf16_t, WS_Z); bf16_t* A2 = WSP(bf16_t, WS_A2);
                for (int it = bid; it < 64 * (NSEG - 1); it += G) scan_prompt<1>(lds, wave, it & 63, it >> 6, Qb, LOGF, Vb, Zb, A2, gn, nullptr, WSP(float, WS_SL), WSP(float, WS_DSEG));
                if (G == 256) {
                    if (bid >= 192) for (int it = 4 * (bid - 192); it < 4 * (bid - 192) + 4; ++it) scan_sample(lds, wave, it, Qb, LOGF, Vb, Zb, A2, gn, s0, s1);
                } else for (int it = bid; it < NSMP * 8; it += G) scan_sample(lds, wave, it, Qb, LOGF, Vb, Zb, A2, gn, s0, s1);
            }
            SEAM();
            if (RUN_PHASE) { KArgs* A = ka_ptr();
                const float* gn = A->in[8] + j * 256;
                float* sp_out = A->out + OUT_SP + (size_t)j * 8 * 8 * 128 * 256;
                const bf16_t* Qb = WSP(bf16_t, WS_Q); const f16_t* LOGF = WSP(f16_t, WS_LOGF); const bf16_t* Vb = WSP(bf16_t, WS_V); const bf16_t* Zb = WSP(bf16_t, WS_Z); bf16_t* A2 = WSP(bf16_t, WS_A2);
                for (int it = bid; it < 64 * NSEG; it += G) scan_prompt<0>(lds, wave, it & 63, it >> 6, Qb, LOGF, Vb, Zb, A2, gn, sp_out, WSP(float, WS_SL), WSP(float, WS_DSEG));
                if (G == 256) {
                    const float* s0 = A->in[2] + (size_t)j * 128 * 8 * 128 * 256; float* s1 = A->out + OUT_SS + (size_t)j * 128 * 8 * 128 * 256;
                    for (int it = 256 + 3 * bid; it < 256 + 3 * bid + 3; ++it) scan_sample(lds, wave, it, Qb, LOGF, Vb, Zb, A2, gn, s0, s1);
                }
            }
            SEAM();
        } else {
            if (RUN_PHASE) { KArgs* A = ka_ptr(); pg8::Gemm g{WSP(bf16_t, WS_HB), WSP(bf16_t, WS_WINB) + (size_t)j * 6144 * 1024, 0, 0}; pg8::Order S; S.init(MP, 6144, 1, G, bid);
                pg8::EpiInB E{WSP(bf16_t, WS_U), WSP(bf16_t, WS_V), WSP(float, WS_SSPB), WSP(float, WS_LNST)}; pg8::gemm_phase<1024>(lds, wave, g, S, E);
                TEpiInB TE{WSP(bf16_t, WS_U), WSP(bf16_t, WS_V), WSP(float, WS_SSSB)}; thin_gemm<1024, 2, 8>(lds, wave, WSP(bf16_t, WS_HB) + (size_t)MP * 1024, 0, WSP(bf16_t, WS_WINB) + (size_t)j * 6144 * 1024, 0, 6144, 1, bid, G, TE); }
            SEAM();
            if (RUN_PHASE) { KArgs* A = ka_ptr();
                const float* wsp = A->in[13] + (size_t)j * 8 * 128 * 128; const float* bsp = A->in[14] + j * 8 * 128;
                const float* lng = A->in[11] + j * 2048; const float* lnb = A->in[12] + j * 2048;
                const bf16_t* Vb = WSP(bf16_t, WS_V); const bf16_t* Ub = WSP(bf16_t, WS_U); bf16_t* A2 = WSP(bf16_t, WS_A2);
                for (int it = bid; it < NB * 16 * 8; it += G) spatial_item(lds, wave, it, wsp, bsp, Vb, Ub, A2, WSP(float, WS_LNST), lng, lnb, A->out + OUT_CVP + (size_t)j * NB * 128 * 2048);
                const int lane = lane_id_v();
                for (int r = gw; r < NSMP; r += NGW) { const size_t ro = (size_t)(MP + r) * 2048;
                    ln_gate_sample_row(Vb + ro, Ub + ro, A2 + ro, lng, lnb, wsp, bsp, A->out + OUT_CVS + ((size_t)j * NSMP + r) * 2048, lane); }
            }
            SEAM();
        }
        if (RUN_PHASE) { KArgs* A = ka_ptr(); pg8::Gemm g{WSP(bf16_t, WS_A2), ((li & 1) ? WSP(bf16_t, WS_WOUTB) : WSP(bf16_t, WS_WOUTA)) + (size_t)j * 1024 * 2048, 0, 0}; pg8::Order S; S.init(MP, 1024, 1, G, bid);
            pg8::EpiRes E{li == 0 ? A->in[0] : nullptr, WSP(bf16_t, WS_HB), WSP(bf16_t, WS_HBA), WSP(float, WS_SSPA)}; pg8::gemm_phase<2048>(lds, wave, g, S, E);
            TEpiRes TE{li == 0 ? A->in[1] - (size_t)MP * 1024 : nullptr, WSP(bf16_t, WS_HB), WSP(bf16_t, WS_HBA), WSP(float, WS_SSSA)}; thin_gemm<2048, 1, 2>(lds, wave, WSP(bf16_t, WS_A2) + (size_t)MP * 2048, 0, ((li & 1) ? WSP(bf16_t, WS_WOUTB) : WSP(bf16_t, WS_WOUTA)) + (size_t)j * 1024 * 2048, 0, 1024, 1, bid, G, TE); }
        SEAM();
        if (RUN_PHASE) { KArgs* A = ka_ptr(); pg8::Gemm g{WSP(bf16_t, WS_HBA), WSP(bf16_t, WS_WG) + (size_t)li * 1024 * 1024, 0, 0}; pg8::Order S; S.init(MP, 1024, 1, G, bid);
            pg8::EpiGate E{WSP(bf16_t, WS_HBA), WSP(bf16_t, WS_PLE) + (size_t)li * MPAD * 1024, WSP(float, WS_SSPA), WSP(bf16_t, WS_HB), WSP(float, WS_H), WSP(float, WS_SSPB)}; pg8::gemm_phase<1024>(lds, wave, g, S, E);
            TEpiGate TE{WSP(bf16_t, WS_HBA), WSP(bf16_t, WS_PLE) + (size_t)li * MPAD * 1024, WSP(float, WS_SSSA), WSP(bf16_t, WS_HB), WSP(float, WS_H), WSP(float, WS_SSSB)}; thin_gemm<1024, 1, 2>(lds, wave, WSP(bf16_t, WS_HBA) + (size_t)MP * 1024, 0, WSP(bf16_t, WS_WG) + (size_t)li * 1024 * 1024, 0, 1024, 1, bid, G, TE); }
        SEAM();
    }
    if (RUN_PHASE) { KArgs* A = ka_ptr();
        const int lane = lane_id_v();
        for (int m = gw; m < MR; m += NGW) {
            float t = m < MP ? (lane < 16 ? WSP(float, WS_SSPB)[(size_t)m * 16 + lane] : 0.f) : WSP(float, WS_SSSB)[(size_t)(m - MP) * 64 + lane];
            const float rs = 1.0f / sqrtf(wave_sum(t) * (1.0f / 1024.0f) + EPS);
            const u32x2* hb = (const u32x2*)(WSP(bf16_t, WS_HB) + (size_t)m * 1024); const f32x4* gf = (const f32x4*)A->in[19]; f32x4* yo = (f32x4*)(A->out + OUT_Y + (size_t)m * 1024);
#pragma unroll
            for (int jq = 0; jq < 4; ++jq) { const u32x2 h = hb[lane + 64 * jq]; const f32x4 g4 = gf[lane + 64 * jq];
                yo[lane + 64 * jq] = (f32x4){bf_lo(h.x) * rs * g4[0], bf_hi(h.x) * rs * g4[1], bf_lo(h.y) * rs * g4[2], bf_hi(h.y) * rs * g4[3]}; }
        }
    }
    SEAM();
#undef RUN_PHASE
#undef SEAM
}

extern "C" void kernel_launch(void* const* d_in, const int* in_sizes, int n_in, void* d_out, int out_size, void* d_ws, size_t ws_size, hipStream_t stream) {
    static int grid = 0;
    if (grid == 0) {
        if (n_in != 20 || (size_t)out_size != OUT_END || ws_size < WS_END) { fprintf(stderr, "kernel_launch: unexpected shapes (n_in %d, out %d, ws %zu; need %zu)\n", n_in, out_size, ws_size, (size_t)WS_END); grid = -1; return; }
        int dev = 0, cus = 0, per_cu = 0;
        (void)hipGetDevice(&dev); (void)hipDeviceGetAttribute(&cus, hipDeviceAttributeMultiprocessorCount, dev);
        if (hipFuncSetAttribute((const void*)fwd_kernel, hipFuncAttributeMaxDynamicSharedMemorySize, LDS_BYTES) != hipSuccess) { fprintf(stderr, "kernel_launch: hipFuncSetAttribute failed\n"); grid = -1; return; }
        if (hipOccupancyMaxActiveBlocksPerMultiprocessor(&per_cu, (const void*)fwd_kernel, NTHREADS, LDS_BYTES) != hipSuccess || per_cu < 1) { fprintf(stderr, "kernel_launch: occupancy query gave %d\n", per_cu); per_cu = 1; }
        (void)hipGetLastError();
        grid = cus * per_cu;
    }
    if (grid < 0) return;
    if (hipMemsetAsync((char*)d_ws + WS_CTR, 0, 16384, stream) != hipSuccess) { fprintf(stderr, "kernel_launch: memset of the barrier words failed\n"); return; }
    Args a{};
    for (int i = 0; i < 20; ++i) a.in[i] = (const float*)d_in[i];
    a.out = (float*)d_out; a.ws = (unsigned char*)d_ws;
#if N_LAUNCH_MODE == 1
    a.ph_lo = 0; a.ph_hi = N_PHASES;
    void* kargs[] = {&a};
    hipError_t e = hipLaunchCooperativeKernel((const void*)fwd_kernel, dim3(grid), dim3(NTHREADS), kargs, LDS_BYTES, stream);
    if (e != hipSuccess) fprintf(stderr, "kernel_launch: cooperative launch failed: %s (grid %d)\n", hipGetErrorString(e), grid);
#else
    for (int p = 0; p < N_PHASES; ++p) { a.ph_lo = p; a.ph_hi = p + 1; hipLaunchKernelGGL(fwd_kernel, dim3(grid), dim3(NTHREADS), LDS_BYTES, stream, a); }
#endif
}
```

```cpp
#include <hip/hip_runtime.h>
#include <hip/hip_cooperative_groups.h>
#include <cstdio>
#include <cstdint>
namespace cg = cooperative_groups;

#ifndef N_LAUNCH_MODE
#define N_LAUNCH_MODE 1
#endif

#ifndef REP_SCAN
#define REP_SCAN 1
#endif
#ifndef REP_INPROJ
#define REP_INPROJ 1
#endif
#ifndef REP_NORM
#define REP_NORM 1
#endif
#ifndef REP_SPATIAL
#define REP_SPATIAL 1
#endif
#ifndef REP_SYNC
#define REP_SYNC 1
#endif
#define DI __device__ __forceinline__
#define LAS __attribute__((address_space(3)))
typedef unsigned short bf16_t;
typedef short bf16x8 __attribute__((ext_vector_type(8)));
typedef short s16x4 __attribute__((ext_vector_type(4)));
typedef float f32x4 __attribute__((ext_vector_type(4)));
typedef unsigned u32x4 __attribute__((ext_vector_type(4)));
typedef unsigned u32x2 __attribute__((ext_vector_type(2)));

constexpr int DM = 1024, SEQ = 2048, NB = 8, NSMP = 128, DI_ = 2048, NH = 8, DK = 128, DV = 256, PLE_D = 256;
constexpr int MP = NB * SEQ;
constexpr int MR = MP + NSMP;
constexpr int MPAD = 16640;
constexpr float EPS = 1e-6f;
constexpr int NTHREADS = 512, NWAVES = 8;
constexpr int LDS_BYTES = 147456;

constexpr size_t SZ_WIN = (size_t)6144 * 1024 * 2, SZ_WOUT = (size_t)1024 * 2048 * 2, SZ_WG = (size_t)1024 * 1024 * 2, SZ_WP = (size_t)1024 * 256 * 2;
constexpr size_t WS_WINA = 0;
constexpr size_t WS_WOUTA = WS_WINA + 2 * SZ_WIN;
constexpr size_t WS_WINB = WS_WOUTA + 2 * SZ_WOUT;
constexpr size_t WS_WOUTB = WS_WINB + 2 * SZ_WIN;
constexpr size_t WS_WG = WS_WOUTB + 2 * SZ_WOUT;
constexpr size_t WS_WP = WS_WG + 4 * SZ_WG;
constexpr size_t WS_LB = WS_WP + 4 * SZ_WP;
constexpr size_t WS_H = WS_LB + 8192;
constexpr size_t WS_HB = WS_H + (size_t)MPAD * 1024 * 4;
constexpr size_t WS_PB = WS_HB + (size_t)MPAD * 1024 * 2;
constexpr size_t WS_PLE = WS_PB + (size_t)4 * MPAD * 256 * 2;
constexpr size_t WS_Q = WS_PLE + (size_t)4 * MPAD * 1024 * 2;
constexpr size_t WS_LOGF = WS_Q + (size_t)MPAD * 1024 * 2;
constexpr size_t WS_V = WS_LOGF + (size_t)MPAD * 1024 * 4;
constexpr size_t WS_Z = WS_V + (size_t)MPAD * 2048 * 2;
constexpr size_t WS_U = WS_Z + (size_t)MPAD * 2048 * 2;
constexpr size_t WS_A2 = WS_U + (size_t)MPAD * 2048 * 2;
constexpr size_t WS_SL = WS_A2 + (size_t)MPAD * 2048 * 2;
constexpr size_t WS_DSEG = WS_SL + (size_t)64 * 3 * 128 * 256 * 4;
constexpr size_t WS_CTR = WS_DSEG + (size_t)64 * 3 * 128 * 4;
constexpr size_t WS_HBA = WS_CTR + 16384;
constexpr size_t WS_SSPA = WS_HBA + (size_t)MPAD * 1024 * 2;
constexpr size_t WS_SSPB = WS_SSPA + (size_t)MP * 16 * 4;
constexpr size_t WS_SSSA = WS_SSPB + (size_t)MP * 16 * 4;
constexpr size_t WS_SSSB = WS_SSSA + (size_t)128 * 64 * 4;
constexpr size_t WS_LNST = WS_SSSB + (size_t)128 * 64 * 4;
constexpr size_t WS_END = WS_LNST + (size_t)MP * 64 * 4;

constexpr size_t OUT_Y = 0;
constexpr size_t OUT_SP = (size_t)MR * 1024;
constexpr size_t OUT_SS = OUT_SP + (size_t)2 * 8 * 8 * 128 * 256;
constexpr size_t OUT_CVP = OUT_SS + (size_t)2 * 128 * 8 * 128 * 256;
constexpr size_t OUT_CVS = OUT_CVP + (size_t)2 * 8 * 128 * 2048;
constexpr size_t OUT_END = OUT_CVS + (size_t)2 * 128 * 2048;

typedef __bf16 bf16x2_t __attribute__((ext_vector_type(2)));
typedef float f32x2_t __attribute__((ext_vector_type(2)));
DI unsigned pk_bf16(float lo, float hi) { const bf16x2_t r = __builtin_convertvector((f32x2_t){lo, hi}, bf16x2_t); return __builtin_bit_cast(unsigned, r); }
typedef _Float16 h16x2_t __attribute__((ext_vector_type(2)));
typedef unsigned short f16_t;
DI unsigned pk_f16(float lo, float hi) { const h16x2_t r = __builtin_convertvector((f32x2_t){lo, hi}, h16x2_t); return __builtin_bit_cast(unsigned, r); }
DI float f16_lo(unsigned u) { const h16x2_t r = __builtin_bit_cast(h16x2_t, u); return (float)r[0]; }
DI float f16_hi(unsigned u) { const h16x2_t r = __builtin_bit_cast(h16x2_t, u); return (float)r[1]; }
DI float bf_lo(unsigned u) { return __uint_as_float(u << 16); }
DI float bf_hi(unsigned u) { return __uint_as_float(u & 0xffff0000u); }
DI int lane_id_v() { int l; asm volatile("v_mbcnt_lo_u32_b32 %0, -1, 0\n\tv_mbcnt_hi_u32_b32 %0, -1, %0" : "=v"(l)); return l; }
DI float sigm(float x) { return __builtin_amdgcn_rcpf(1.0f + __expf(-x)); }
DI float silu_f(float x) { return x * sigm(x); }
DI float gelu_f(float x) { const float u = 1.5957691216f * (x + 0.044715f * x * x * x); return x * sigm(u); }
DI float wave_sum(float v) {
#pragma unroll
    for (int o = 1; o < 64; o <<= 1) v += __shfl_xor(v, o);
    return v;
}
template <int ACT> DI float act_f(float x) { if (ACT == 1) return silu_f(x); if (ACT == 2) return gelu_f(x); return x; }
constexpr unsigned TS = 272;
DI unsigned off_b(unsigned row, unsigned ch) { return TS * row + 16u * ch; }
DI unsigned tr_addr16(unsigned lane, unsigned c, unsigned ks, unsigned t) {
    const unsigned g = lane >> 4, q = (lane & 15) >> 2, p = lane & 3;
    return off_b(32 * ks + 8 * g + 4 * t + q, 2 * c + (p >> 1)) + 8 * (p & 1);
}
DI bf16x8 tr_frag(LAS unsigned char* img, unsigned lane, unsigned c, unsigned ks) {
    const s16x4 a = __builtin_amdgcn_ds_read_tr16_b64_v4i16((LAS s16x4*)(img + tr_addr16(lane, c, ks, 0)));
    const s16x4 b = __builtin_amdgcn_ds_read_tr16_b64_v4i16((LAS s16x4*)(img + tr_addr16(lane, c, ks, 1)));
    return (bf16x8){a[0], a[1], a[2], a[3], b[0], b[1], b[2], b[3]};
}
DI f32x4 mfma16(bf16x8 a, bf16x8 b, f32x4 c) { return __builtin_amdgcn_mfma_f32_16x16x32_bf16(a, b, c, 0, 0, 0); }

namespace pg8 {
constexpr int BM = 256, BK = 64, HALF = 128, HTB = HALF * BK * 2, STAGE_BYTES = 8 * HTB, NXCD = 8, WGM = 8;
DI int lds_byte(int r, int c) { const int st = (r >> 4) * 2 + (c >> 5), rr = r & 15, cc = c & 31, ob = rr * 64 + cc * 2; return st * 1024 + (ob ^ (((ob >> 9) & 1) << 5)); }
DI void stage_rc(int b, int& R, int& C) { const int st = b / 1024, sb = b % 1024, swz = sb ^ (((sb >> 9) & 1) << 5); R = (st >> 1) * 16 + swz / 64; C = (st & 1) * 32 + (swz % 64) / 2; }
DI int perm32(int rho) { const int n = rho >> 4, i = rho & 15; return 8 * (i >> 2) + 4 * n + (i & 3); }

struct Unit { int pm, pn, z; };
struct Gemm { const bf16_t* A; const bf16_t* Bt; size_t Az, Bz; };
struct Order {
    int nM, nN, nZ, nwg, G, c;
    DI void init(int M, int N, int Z, int G_, int c_) { nM = M / BM; nN = N / BM; nZ = Z; nwg = nM * nN; G = G_; c = c_; }
    DI bool next(int i, Unit& u) const {
        const long L = (long)i * G + c; if (L >= (long)nwg * nZ) return false;
        u.z = (int)(L / nwg); int wgid = (int)(L % nwg);
        { const int q = nwg / NXCD, r = nwg % NXCD, xcd = wgid % NXCD, off = wgid / NXCD; wgid = (xcd < r ? xcd * (q + 1) : r * (q + 1) + (xcd - r) * q) + off; }
        const int nig = WGM * nN, gid = wgid / nig, fm = gid * WGM, gsz = (nM - fm) < WGM ? (nM - fm) : WGM;
        u.pm = fm + ((wgid % nig) % gsz); u.pn = (wgid % nig) / gsz; return true;
    }
};

DI void load_rs(const float* SSP, int row0, float (&rs)[2][4]) {
#pragma unroll
    for (int ai = 0; ai < 2; ++ai)
#pragma unroll
        for (int m = 0; m < 4; ++m) { const f32x4* p = (const f32x4*)(SSP + (size_t)(row0 + ai * HALF + m * 16) * 16); const f32x4 a = p[0], b = p[1], c = p[2], d = p[3];
            const float t = ((a[0] + a[1]) + (a[2] + a[3])) + ((b[0] + b[1]) + (b[2] + b[3])) + ((c[0] + c[1]) + (c[2] + c[3])) + ((d[0] + d[1]) + (d[2] + d[3]));
            rs[ai][m] = 1.0f / sqrtf(t * (1.0f / 1024.0f) + EPS); }
}
constexpr int RSN_OFF = 131072;
struct RsPre { f32x4 a, b, c, d; };
DI RsPre rs_pre_load(const float* SSP, int pm, int tid) { RsPre r; const f32x4* p = (const f32x4*)(SSP + (size_t)(pm * BM + (tid & 255)) * 16); r.a = p[0]; r.b = p[1]; r.c = p[2]; r.d = p[3]; return r; }
DI void rs_pre_store(LAS unsigned char* lds, const RsPre& r, int slot, int tid) {
    const float t = ((r.a[0] + r.a[1]) + (r.a[2] + r.a[3])) + ((r.b[0] + r.b[1]) + (r.b[2] + r.b[3])) + ((r.c[0] + r.c[1]) + (r.c[2] + r.c[3])) + ((r.d[0] + r.d[1]) + (r.d[2] + r.d[3]));
    if (tid < 256) ((LAS float*)(lds + RSN_OFF))[slot * 256 + tid] = 1.0f / sqrtf(t * (1.0f / 1024.0f) + EPS);
}
DI void load_rs_lds(LAS unsigned char* lds, int slot, int wr, int fr, float (&rs)[2][4]) {
#pragma unroll
    for (int ai = 0; ai < 2; ++ai)
#pragma unroll
        for (int m = 0; m < 4; ++m) rs[ai][m] = ((LAS float*)(lds + RSN_OFF))[slot * 256 + ai * HALF + wr * 64 + m * 16 + fr];
}
template <int ACT> DI void store_bf16_tile(const f32x4 (&acc)[2][2][4][2], bf16_t* dst, int ld, const float (&rs)[2][4], size_t bjs = HALF) {
#pragma unroll
    for (int ai = 0; ai < 2; ++ai)
#pragma unroll
        for (int m = 0; m < 4; ++m) { bf16_t* rp = dst + (size_t)(ai * HALF + m * 16) * ld;
#pragma unroll
            for (int bj = 0; bj < 2; ++bj) { const f32x4 v0 = acc[ai][bj][m][0] * rs[ai][m], v1 = acc[ai][bj][m][1] * rs[ai][m];
                u32x4 w; w.x = pk_bf16(act_f<ACT>(v0[0]), act_f<ACT>(v0[1])); w.y = pk_bf16(act_f<ACT>(v0[2]), act_f<ACT>(v0[3]));
                w.z = pk_bf16(act_f<ACT>(v1[0]), act_f<ACT>(v1[1])); w.w = pk_bf16(act_f<ACT>(v1[2]), act_f<ACT>(v1[3]));
                *(u32x4*)(rp + bj * bjs) = w; } }
}
struct EpiInA {
    static constexpr bool PERM = true;
    static constexpr bool HAS_PRE = true;
    bf16_t* Q; f16_t* LOGF; bf16_t* V; bf16_t* Z; const float* lb; const float* SSP;
    DI void operator()(const f32x4 (&acc)[2][2][4][2], const Unit& u, int wr, int wc, int fr, int fq, LAS unsigned char* lds, int slot) const {
        const int row0 = u.pm * BM + wr * 64 + fr, colt = u.pn * BM, cl = wc * 32 + 8 * fq;
        float rs[2][4]; load_rs_lds(lds, slot, wr, fr, rs);
        const size_t bb = (size_t)(u.pm >> 3) * 8; const int t0 = (u.pm & 7) * BM + wr * 64 + fr;
        if (colt < 1024) store_bf16_tile<1>(acc, Q + ((bb + (colt >> 7)) * SEQ + t0) * 128 + cl, 128, rs, (size_t)SEQ * 128);
        else if (colt < 2048) {
            const int c0 = colt - 1024 + cl;
#pragma unroll
            for (int bj = 0; bj < 2; ++bj)
#pragma unroll
                for (int n = 0; n < 2; ++n) { const f32x4 lbv = *(const f32x4*)(lb + c0 + bj * HALF + 4 * n);
#pragma unroll
                    for (int ai = 0; ai < 2; ++ai)
#pragma unroll
                        for (int m = 0; m < 4; ++m) { const f32x4 x = acc[ai][bj][m][n] * rs[ai][m]; f32x4 o;
#pragma unroll
                            for (int e = 0; e < 4; ++e) { const float f = lbv[e] + (1.0f - lbv[e]) * sigm(x[e]); o[e] = __logf(f); }
                            u32x2 oh; oh.x = pk_f16(o[0], o[1]); oh.y = pk_f16(o[2], o[3]);
                            *(u32x2*)(LOGF + ((bb + ((colt - 1024) >> 7) + bj) * SEQ + t0 + ai * HALF + m * 16) * 128 + cl + 4 * n) = oh; } }
        }
        else if (colt < 4096) store_bf16_tile<0>(acc, V + ((bb + ((colt - 2048) >> 8)) * SEQ + t0) * 256 + cl, 256, rs);
        else store_bf16_tile<1>(acc, Z + ((bb + ((colt - 4096) >> 8)) * SEQ + t0) * 256 + cl, 256, rs);
    }
};
struct EpiInB {
    static constexpr bool PERM = true;
    static constexpr bool HAS_PRE = true;
    bf16_t* UZ; bf16_t* GV; const float* SSP; float* LNST;
    DI void operator()(const f32x4 (&acc)[2][2][4][2], const Unit& u, int wr, int wc, int fr, int fq, LAS unsigned char* lds, int slot_rs) const {
        const int row0 = u.pm * BM + wr * 64 + fr, colt = u.pn * BM, cl = wc * 32 + 8 * fq;
        float rs[2][4]; load_rs_lds(lds, slot_rs, wr, fr, rs);
        if (colt < 4096) {
            bf16_t* dst = UZ + (size_t)row0 * 2048 + ((colt + cl) >> 1);
#pragma unroll
            for (int ai = 0; ai < 2; ++ai)
#pragma unroll
                for (int m = 0; m < 4; ++m) { bf16_t* rp = dst + (size_t)(ai * HALF + m * 16) * 2048;
#pragma unroll
                    for (int bj = 0; bj < 2; ++bj) { const f32x4 v0 = acc[ai][bj][m][0] * rs[ai][m], v1 = acc[ai][bj][m][1] * rs[ai][m];
                        u32x2 w; w.x = pk_bf16(gelu_f(v0[0]) * silu_f(v1[0]), gelu_f(v0[1]) * silu_f(v1[1])); w.y = pk_bf16(gelu_f(v0[2]) * silu_f(v1[2]), gelu_f(v0[3]) * silu_f(v1[3]));
                        *(u32x2*)(rp + bj * (HALF / 2)) = w; } }
        } else {
            bf16_t* dst = GV + (size_t)row0 * 2048 + (colt - 4096) + cl; const int slot = (u.pn - 16) * 4 + wc;
#pragma unroll
            for (int ai = 0; ai < 2; ++ai)
#pragma unroll
                for (int m = 0; m < 4; ++m) { bf16_t* rp = dst + (size_t)(ai * HALF + m * 16) * 2048; float s1 = 0.f, s2 = 0.f;
#pragma unroll
                    for (int bj = 0; bj < 2; ++bj) { f32x4 v0 = acc[ai][bj][m][0] * rs[ai][m], v1 = acc[ai][bj][m][1] * rs[ai][m];
#pragma unroll
                        for (int e = 0; e < 4; ++e) { v0[e] = gelu_f(v0[e]); v1[e] = gelu_f(v1[e]); s1 += v0[e] + v1[e]; s2 += v0[e] * v0[e] + v1[e] * v1[e]; }
                        u32x4 w; w.x = pk_bf16(v0[0], v0[1]); w.y = pk_bf16(v0[2], v0[3]); w.z = pk_bf16(v1[0], v1[1]); w.w = pk_bf16(v1[2], v1[3]);
                        *(u32x4*)(rp + bj * HALF) = w; }
                    s1 += __shfl_xor(s1, 16); s1 += __shfl_xor(s1, 32); s2 += __shfl_xor(s2, 16); s2 += __shfl_xor(s2, 32);
                    if (fq == 0) { float* st = LNST + ((size_t)(row0 + ai * HALF + m * 16) * 32 + slot) * 2; st[0] = s1; st[1] = s2; } }
        }
    }
};
struct EpiPle {
    static constexpr bool PERM = true; static constexpr bool HAS_PRE = false;
    bf16_t* PLE;
    DI void operator()(const f32x4 (&acc)[2][2][4][2], const Unit& u, int wr, int wc, int fr, int fq, LAS unsigned char*, int) const {
        const int row0 = u.pm * BM + wr * 64 + fr, colt = u.pn * BM, cl = wc * 32 + 8 * fq;
        const float rs[2][4] = {{1.f, 1.f, 1.f, 1.f}, {1.f, 1.f, 1.f, 1.f}};
        store_bf16_tile<0>(acc, PLE + (size_t)u.z * MPAD * 1024 + (size_t)row0 * 1024 + colt + cl, 1024, rs);
    }
};
struct EpiRes {
    static constexpr bool PERM = false; static constexpr bool HAS_PRE = false;
    const float* Xin; const bf16_t* HBin; bf16_t* HBo; float* SSPo;
    DI void operator()(const f32x4 (&acc)[2][2][4][2], const Unit& u, int wr, int wc, int fr, int fq, LAS unsigned char*, int) const {
        const int row0 = u.pm * BM + wr * 64 + fr, col0 = u.pn * BM + wc * 32 + 4 * fq;
#pragma unroll
        for (int ai = 0; ai < 2; ++ai)
#pragma unroll
            for (int m = 0; m < 4; ++m) { const int row = row0 + ai * HALF + m * 16; const size_t ro = (size_t)row * 1024 + col0; float ss = 0.f;
#pragma unroll
                for (int bj = 0; bj < 2; ++bj)
#pragma unroll
                    for (int n = 0; n < 2; ++n) { f32x4 h;
                        if (Xin) h = *(const f32x4*)(Xin + ro + bj * HALF + n * 16);
                        else { const u32x2 hb = *(const u32x2*)(HBin + ro + bj * HALF + n * 16); h = (f32x4){bf_lo(hb.x), bf_hi(hb.x), bf_lo(hb.y), bf_hi(hb.y)}; }
                        h += acc[ai][bj][m][n];
                        ss += (h[0] * h[0] + h[1] * h[1]) + (h[2] * h[2] + h[3] * h[3]);
                        u32x2 w; w.x = pk_bf16(h[0], h[1]); w.y = pk_bf16(h[2], h[3]); *(u32x2*)(HBo + ro + bj * HALF + n * 16) = w; }
                ss += __shfl_xor(ss, 16); ss += __shfl_xor(ss, 32);
                if (fq == 0) SSPo[(size_t)row * 16 + u.pn * 4 + wc] = ss;
                if (m & 1) asm volatile("" ::: "memory"); }
    }
};
struct EpiGate {
    static constexpr bool PERM = false; static constexpr bool HAS_PRE = true;
    const bf16_t* HBin; const bf16_t* PLE; const float* SSP; bf16_t* HBo; float* Hout; float* SSPo;
    DI void operator()(const f32x4 (&acc)[2][2][4][2], const Unit& u, int wr, int wc, int fr, int fq, LAS unsigned char* lds, int slot) const {
        const int row0 = u.pm * BM + wr * 64 + fr, col0 = u.pn * BM + wc * 32 + 4 * fq;
        float rs[2][4]; load_rs_lds(lds, slot, wr, fr, rs);
#pragma unroll
        for (int ai = 0; ai < 2; ++ai)
#pragma unroll
            for (int m = 0; m < 4; ++m) { const int row = row0 + ai * HALF + m * 16; const size_t ro = (size_t)row * 1024 + col0; float ss = 0.f;
#pragma unroll
                for (int bj = 0; bj < 2; ++bj)
#pragma unroll
                    for (int n = 0; n < 2; ++n) { const u32x2 hb = *(const u32x2*)(HBin + ro + bj * HALF + n * 16), pl = *(const u32x2*)(PLE + ro + bj * HALF + n * 16);
                        const f32x4 a = acc[ai][bj][m][n] * rs[ai][m]; f32x4 h = (f32x4){bf_lo(hb.x), bf_hi(hb.x), bf_lo(hb.y), bf_hi(hb.y)};
                        h[0] += sigm(a[0]) * bf_lo(pl.x); h[1] += sigm(a[1]) * bf_hi(pl.x); h[2] += sigm(a[2]) * bf_lo(pl.y); h[3] += sigm(a[3]) * bf_hi(pl.y);
                        if (HBo) { ss += (h[0] * h[0] + h[1] * h[1]) + (h[2] * h[2] + h[3] * h[3]);
                            u32x2 w; w.x = pk_bf16(h[0], h[1]); w.y = pk_bf16(h[2], h[3]); *(u32x2*)(HBo + ro + bj * HALF + n * 16) = w; }
                        else *(f32x4*)(Hout + ro + bj * HALF + n * 16) = h; }
                if (HBo) { ss += __shfl_xor(ss, 16); ss += __shfl_xor(ss, 32); if (fq == 0) SSPo[(size_t)row * 16 + u.pn * 4 + wc] = ss; }
                if (m & 1) asm volatile("" ::: "memory"); }
    }
};

template <int K, class Epi>
DI void gemm_phase(LAS unsigned char* lds, const int wid_in, const Gemm g, const Order& S, const Epi& E) {
    int wid = wid_in; asm volatile("" : "+s"(wid));
    const int lane = lane_id_v(), tid = wid * 64 + lane, wr = wid >> 2, wc = wid & 3, fr = lane & 15, fq = lane >> 4;
    constexpr int nt = K / BK;
    unsigned voffA, voffB;
    { int R, C; stage_rc(tid * 16, R, C); const int Rb = Epi::PERM ? ((R & ~31) + perm32(R & 31)) : R;
        voffA = (unsigned)(R * K + C) * 2u; voffB = (unsigned)(Rb * K + C) * 2u; }
    constexpr size_t kstep = (size_t)(BK * 2);
    constexpr size_t hstep = (size_t)HALF * K * 2;
    constexpr size_t tstep = 2 * hstep;
    const unsigned ldsw = (unsigned)wid * 1024u;
    const int aoff = lds_byte(wr * 64 + fr, fq * 8), boff = lds_byte(wc * 32 + fr, fq * 8);
#define PG8_SA(b, h) (((b) * 2 + (h)) * HTB)
#define PG8_SB(b, h) ((4 + (b) * 2 + (h)) * HTB)
#define PG8_STAGE(bufoff, gbase, voff) do { _Pragma("unroll") for (int _i = 0; _i < 2; ++_i) \
        __builtin_amdgcn_global_load_lds((const unsigned*)((const char*)(gbase) + (size_t)_i * (64 * K * 2) + (voff)), (LAS unsigned*)(lds + (bufoff) + ldsw + _i * 8192), 16, 0, 0); } while (0)
#define PG8_LDA(dst, b, h) do { _Pragma("unroll") for (int m = 0; m < 4; ++m) _Pragma("unroll") for (int k = 0; k < 2; ++k) dst[m][k] = *(const LAS bf16x8*)(lds + PG8_SA(b, h) + aoff + m * 2048 + k * 1024); } while (0)
#define PG8_LDB(dst, b, h) do { _Pragma("unroll") for (int n = 0; n < 2; ++n) _Pragma("unroll") for (int k = 0; k < 2; ++k) dst[n][k] = *(const LAS bf16x8*)(lds + PG8_SB(b, h) + boff + n * 2048 + k * 1024); } while (0)
#define PG8_MMA(ai, bj, At, Bt) do { __builtin_amdgcn_s_setprio(1); _Pragma("unroll") for (int m = 0; m < 4; ++m) _Pragma("unroll") for (int n = 0; n < 2; ++n) _Pragma("unroll") for (int k = 0; k < 2; ++k) \
        acc[ai][bj][m][n] = __builtin_amdgcn_mfma_f32_16x16x32_bf16(Bt[n][k], At[m][k], acc[ai][bj][m][n], 0, 0, 0); __builtin_amdgcn_s_setprio(0); } while (0)
#define PG8_WAIT_V(n) asm volatile("s_waitcnt vmcnt(" #n ")" ::: "memory")
#define PG8_WAIT_L(n) asm volatile("s_waitcnt lgkmcnt(" #n ")" ::: "memory")
#define PG8_BAR __builtin_amdgcn_s_barrier()
#define PG8_SCHED __builtin_amdgcn_sched_barrier(0)
    Unit cur, nxt; int ui = 0;
    if (!S.next(0, cur)) return;
    f32x4 acc[2][2][4][2];
#pragma unroll
    for (int a = 0; a < 2; ++a)
#pragma unroll
        for (int b = 0; b < 2; ++b)
#pragma unroll
            for (int m = 0; m < 4; ++m)
#pragma unroll
                for (int n = 0; n < 2; ++n) acc[a][b][m][n] = (f32x4){0.f, 0.f, 0.f, 0.f};
    bf16x8 At[4][2], B0[2][2], B1[2][2];
    const char* cA = (const char*)g.A + (size_t)cur.z * g.Az + (size_t)cur.pm * tstep; const char* cB = (const char*)g.Bt + (size_t)cur.z * g.Bz + (size_t)cur.pn * tstep;
    if constexpr (Epi::HAS_PRE) { const RsPre pf = rs_pre_load(E.SSP, cur.pm, tid); rs_pre_store(lds, pf, 0, tid); }
    PG8_STAGE(PG8_SB(0, 0), cB, voffB); PG8_STAGE(PG8_SB(0, 1), cB + hstep, voffB); PG8_STAGE(PG8_SA(0, 0), cA, voffA); PG8_STAGE(PG8_SA(0, 1), cA + hstep, voffA);
    if (wr == 1) PG8_BAR;
    PG8_WAIT_V(2); PG8_BAR;
    PG8_STAGE(PG8_SB(1, 0), cB + kstep, voffB); PG8_STAGE(PG8_SA(1, 0), cA + kstep, voffA); PG8_STAGE(PG8_SB(1, 1), cB + hstep + kstep, voffB);
    PG8_WAIT_V(6); PG8_BAR;
    for (;;) {
        const bool has_next = S.next(ui + 1, nxt);
        const char* nA = has_next ? (const char*)g.A + (size_t)nxt.z * g.Az + (size_t)nxt.pm * tstep : cA; const char* nB = has_next ? (const char*)g.Bt + (size_t)nxt.z * g.Bz + (size_t)nxt.pn * tstep : cB;
#pragma unroll 1
        for (int t = 0; t < nt; t += 2) {
            const bool last = (t == nt - 2);
            const char* a1 = cA + (size_t)(t + 1) * kstep;
            const char* a2 = last ? nA : cA + (size_t)(t + 2) * kstep; const char* b2 = last ? nB : cB + (size_t)(t + 2) * kstep;
            const char* a3 = a2 + kstep; const char* b3 = b2 + kstep;
            PG8_LDB(B0, 0, 0); PG8_LDB(B1, 0, 1); PG8_SCHED; PG8_LDA(At, 0, 0); PG8_STAGE(PG8_SA(1, 1), a1 + hstep, voffA);
            PG8_WAIT_V(8); PG8_WAIT_L(0); PG8_BAR; PG8_MMA(0, 0, At, B0); PG8_MMA(0, 1, At, B1); PG8_BAR; PG8_SCHED;
            PG8_LDA(At, 0, 1); PG8_STAGE(PG8_SB(0, 0), b2, voffB); PG8_STAGE(PG8_SB(0, 1), b2 + hstep, voffB); PG8_STAGE(PG8_SA(0, 0), a2, voffA);
            PG8_WAIT_V(8); PG8_WAIT_L(0); PG8_BAR; PG8_MMA(1, 0, At, B0); PG8_MMA(1, 1, At, B1); PG8_BAR; PG8_SCHED;
            PG8_LDB(B0, 1, 0); PG8_LDB(B1, 1, 1); PG8_SCHED; PG8_LDA(At, 1, 0); PG8_STAGE(PG8_SA(0, 1), a2 + hstep, voffA);
            PG8_WAIT_V(8); PG8_WAIT_L(0); PG8_BAR; PG8_MMA(0, 0, At, B0); PG8_MMA(0, 1, At, B1); PG8_BAR; PG8_SCHED;
            PG8_LDA(At, 1, 1); PG8_STAGE(PG8_SB(1, 0), b3, voffB); PG8_STAGE(PG8_SB(1, 1), b3 + hstep, voffB); PG8_STAGE(PG8_SA(1, 0), a3, voffA);
            PG8_WAIT_V(8); PG8_WAIT_L(0); PG8_BAR; PG8_MMA(1, 0, At, B0); PG8_MMA(1, 1, At, B1); PG8_BAR; PG8_SCHED;
        }
        if (wr == 0) PG8_BAR;
        if constexpr (Epi::HAS_PRE) {
            RsPre pf; if (has_next) pf = rs_pre_load(E.SSP, nxt.pm, tid);
            E(acc, cur, wr, wc, fr, fq, lds, ui & 1);
            if (has_next) rs_pre_store(lds, pf, (ui + 1) & 1, tid);
        } else E(acc, cur, wr, wc, fr, fq, lds, 0);
        if (!has_next) break;
#pragma unroll
        for (int a = 0; a < 2; ++a)
#pragma unroll
            for (int b = 0; b < 2; ++b)
#pragma unroll
                for (int m = 0; m < 4; ++m)
#pragma unroll
                    for (int n = 0; n < 2; ++n) acc[a][b][m][n] = (f32x4){0.f, 0.f, 0.f, 0.f};
        cur = nxt; cA = nA; cB = nB; ++ui;
        if (wr == 1) PG8_BAR;
    }
    PG8_WAIT_V(0);
    PG8_BAR;
#undef PG8_SA
#undef PG8_SB
#undef PG8_STAGE
#undef PG8_LDA
#undef PG8_LDB
#undef PG8_MMA
#undef PG8_WAIT_V
#undef PG8_WAIT_L
#undef PG8_BAR
#undef PG8_SCHED
}
}


DI float thin_rs(const float* SSS, int row) {
    const f32x4* p = (const f32x4*)(SSS + (size_t)(row - MP) * 64); f32x4 t = p[0];
#pragma unroll
    for (int i = 1; i < 16; ++i) t += p[i];
    return 1.0f / sqrtf(((t[0] + t[1]) + (t[2] + t[3])) * (1.0f / 1024.0f) + EPS);
}
struct TEpiInA { bf16_t* Q; f16_t* LOGF; bf16_t* V; bf16_t* Z; const float* lb; const float* SSS;
    DI float rs_of(int row) const { return thin_rs(SSS, row); }
    DI void operator()(int z, int row, int col, f32x4 v, int lane, float rs) const {
        v *= rs;
        if (col < 1024) { u32x2 o; o.x = pk_bf16(silu_f(v[0]), silu_f(v[1])); o.y = pk_bf16(silu_f(v[2]), silu_f(v[3])); *(u32x2*)(Q + (size_t)row * 1024 + col) = o; }
        else if (col < 2048) { const f32x4 lbv = *(const f32x4*)(lb + col - 1024); f32x4 o;
#pragma unroll
            for (int e = 0; e < 4; ++e) o[e] = __logf(lbv[e] + (1.0f - lbv[e]) * sigm(v[e]));
            u32x2 oh; oh.x = pk_f16(o[0], o[1]); oh.y = pk_f16(o[2], o[3]); *(u32x2*)(LOGF + (size_t)row * 1024 + col - 1024) = oh; }
        else if (col < 4096) { u32x2 o; o.x = pk_bf16(v[0], v[1]); o.y = pk_bf16(v[2], v[3]); *(u32x2*)(V + (size_t)row * 2048 + col - 2048) = o; }
        else { u32x2 o; o.x = pk_bf16(silu_f(v[0]), silu_f(v[1])); o.y = pk_bf16(silu_f(v[2]), silu_f(v[3])); *(u32x2*)(Z + (size_t)row * 2048 + col - 4096) = o; }
    } };
struct TEpiInB { bf16_t* UZ; bf16_t* GV; const float* SSS;
    DI float rs_of(int row) const { return thin_rs(SSS, row); }
    DI void operator()(int z, int row, int col, f32x4 v, int lane, float rs) const {
        v *= rs;
        const bool isz = (col & 4) != 0; f32x4 mine, other;
#pragma unroll
        for (int e = 0; e < 4; ++e) { mine[e] = (col < 4096 && isz) ? silu_f(v[e]) : gelu_f(v[e]); other[e] = __shfl_xor(mine[e], 1); }
        if (col < 4096) { if (!isz) { u32x2 o; o.x = pk_bf16(mine[0] * other[0], mine[1] * other[1]); o.y = pk_bf16(mine[2] * other[2], mine[3] * other[3]); *(u32x2*)(UZ + (size_t)row * 2048 + 4 * (col >> 3)) = o; } }
        else { u32x2 o; o.x = pk_bf16(mine[0], mine[1]); o.y = pk_bf16(mine[2], mine[3]); *(u32x2*)(GV + (size_t)row * 2048 + col - 4096) = o; }
    } };
struct TEpiPle { bf16_t* PLE;
    DI float rs_of(int row) const { return 1.0f; }
    DI void operator()(int z, int row, int col, f32x4 v, int lane, float rs) const { u32x2 o; o.x = pk_bf16(v[0], v[1]); o.y = pk_bf16(v[2], v[3]); *(u32x2*)(PLE + (size_t)z * MPAD * 1024 + (size_t)row * 1024 + col) = o; } };
struct TEpiRes { const float* Xin; const bf16_t* HBin; bf16_t* HBo; float* SSSo;
    DI float rs_of(int row) const { return 1.0f; }
    DI void operator()(int z, int row, int col, f32x4 v, int lane, float rs) const { f32x4 h;
        if (Xin) h = *(const f32x4*)(Xin + (size_t)row * 1024 + col);
        else { const u32x2 hb = *(const u32x2*)(HBin + (size_t)row * 1024 + col); h = (f32x4){bf_lo(hb.x), bf_hi(hb.x), bf_lo(hb.y), bf_hi(hb.y)}; }
        h += v;
        float ss = (h[0] * h[0] + h[1] * h[1]) + (h[2] * h[2] + h[3] * h[3]); ss += __shfl_xor(ss, 1); ss += __shfl_xor(ss, 2);
        if ((lane & 3) == 0) SSSo[(size_t)(row - MP) * 64 + (col >> 4)] = ss;
        u32x2 w; w.x = pk_bf16(h[0], h[1]); w.y = pk_bf16(h[2], h[3]); *(u32x2*)(HBo + (size_t)row * 1024 + col) = w; } };
struct TEpiGate { const bf16_t* HBin; const bf16_t* PLE; const float* SSSi; bf16_t* HBo; float* Hout; float* SSSo;
    DI float rs_of(int row) const { return thin_rs(SSSi, row); }
    DI void operator()(int z, int row, int col, f32x4 v, int lane, float rs) const {
        const u32x2 hb = *(const u32x2*)(HBin + (size_t)row * 1024 + col), pl = *(const u32x2*)(PLE + (size_t)row * 1024 + col);
        f32x4 h = (f32x4){bf_lo(hb.x), bf_hi(hb.x), bf_lo(hb.y), bf_hi(hb.y)};
        v *= rs;
        h[0] += sigm(v[0]) * bf_lo(pl.x); h[1] += sigm(v[1]) * bf_hi(pl.x); h[2] += sigm(v[2]) * bf_lo(pl.y); h[3] += sigm(v[3]) * bf_hi(pl.y);
        if (HBo) { float ss = (h[0] * h[0] + h[1] * h[1]) + (h[2] * h[2] + h[3] * h[3]); ss += __shfl_xor(ss, 1); ss += __shfl_xor(ss, 2);
            if ((lane & 3) == 0) SSSo[(size_t)(row - MP) * 64 + (col >> 4)] = ss;
            u32x2 w; w.x = pk_bf16(h[0], h[1]); w.y = pk_bf16(h[2], h[3]); *(u32x2*)(HBo + (size_t)row * 1024 + col) = w; }
        else *(f32x4*)(Hout + (size_t)row * 1024 + col) = h; } };

template <int K, int NPB, int MT, class Epi>
DI void thin_gemm(LAS unsigned char* lds, const int w, const bf16_t* A  , size_t Az  , const bf16_t* Bt, size_t Bz, const int N, const int nZ,
                  const int bid, const int G, const Epi& E) {
    const int lane = lane_id_v(), tid = w * 64 + lane, fr = lane & 15, fq = lane >> 4;
    constexpr int KW = K / 8, KS = KW / 32;
    constexpr int NMB = 8 / MT;
    LAS float* P = (LAS float*)lds;
    const int npn = N / 16;
    const int ei = tid >> 6, ee = (tid & 63) * 4, er = ee >> 4, ec = ee & 15;
    float rs_row = 1.0f; if (MT == 8) rs_row = E.rs_of(MP + 16 * ei + er);
    for (int p = bid * NPB; p < npn * nZ * NMB; p += G * NPB) {
        const int mblk = p % NMB, pc = p / NMB, z = pc / npn, ng = pc % npn;
        const int mrow = 16 * MT * mblk;
        const bf16_t* a0 = A + (size_t)z * Az + (size_t)(mrow + fr) * K + w * KW + 8 * fq;
        const bf16_t* b0 = Bt + (size_t)z * Bz + (size_t)(16 * ng + fr) * K + w * KW + 8 * fq;
        f32x4 acc[NPB][MT];
#pragma unroll
        for (int q = 0; q < NPB; ++q)
#pragma unroll
            for (int i = 0; i < MT; ++i) acc[q][i] = (f32x4){0.f, 0.f, 0.f, 0.f};
        constexpr int KBM = (NPB > 1 ? 2 : 4) * (8 / MT), KB = KS < KBM ? KS : KBM;
#pragma unroll
        for (int kb = 0; kb < KS; kb += KB) {
            bf16x8 bfr[NPB][KB], afr[KB][MT];
#pragma unroll
            for (int kk = 0; kk < KB; ++kk) {
#pragma unroll
                for (int q = 0; q < NPB; ++q) bfr[q][kk] = *(const bf16x8*)(b0 + (size_t)(16 * q) * K + 32 * (kb + kk));
#pragma unroll
                for (int i = 0; i < MT; ++i) afr[kk][i] = *(const bf16x8*)(a0 + (size_t)(16 * i) * K + 32 * (kb + kk)); }
#pragma unroll
            for (int kk = 0; kk < KB; ++kk)
#pragma unroll
                for (int i = 0; i < MT; ++i)
#pragma unroll
                    for (int q = 0; q < NPB; ++q) acc[q][i] = mfma16(afr[kk][i], bfr[q][kk], acc[q][i]);
        }
        if (MT < 8 && ei < MT) rs_row = E.rs_of(MP + mrow + 16 * ei + er);
#pragma unroll
        for (int q = 0; q < NPB; ++q) {
#pragma unroll
            for (int i = 0; i < MT; ++i)
#pragma unroll
                for (int jj = 0; jj < 4; ++jj) P[(w * MT + i) * 256 + (4 * fq + jj) * 16 + fr] = acc[q][i][jj];
            __syncthreads();
            if (MT == 8 || ei < MT) {
                f32x4 v = (f32x4){0.f, 0.f, 0.f, 0.f};
#pragma unroll
                for (int ww = 0; ww < 8; ++ww) v += *(LAS f32x4*)(P + (ww * MT + ei) * 256 + ee);
                E(z, MP + mrow + 16 * ei + er, 16 * (ng + q) + ec, v, lane, rs_row);
            }
            __syncthreads();
        }
    }
}

DI int uz_row(int n) { return n < 2048 ? 8 * (n >> 2) + (n & 3) : (n < 4096 ? n + 2048 : 8 * ((n - 4096) >> 2) + 4 + (n & 3)); }
template <bool UZMAP = false>
DI void transpose_item(const float* W, int K, int N, bf16_t* WT, LAS float* scr, int item, int lane, const float* kscale = nullptr) {
    const int nblk = N / 32, kb = item / nblk, nb = item % nblk, k0 = 64 * kb, n0 = 32 * nb;
#pragma unroll
    for (int i = 0; i < 8; ++i) { const int kk = 8 * i + (lane >> 3), n4 = (lane & 7) * 4;
        const f32x4 v = *(const f32x4*)(W + (size_t)(k0 + kk) * N + n0 + n4); const float sc = kscale ? kscale[k0 + kk] : 1.0f;
        scr[kk * 33 + n4 + 0] = v[0] * sc; scr[kk * 33 + n4 + 1] = v[1] * sc; scr[kk * 33 + n4 + 2] = v[2] * sc; scr[kk * 33 + n4 + 3] = v[3] * sc; }
    asm volatile("s_waitcnt lgkmcnt(0)" ::: "memory");
    const int c = lane & 7;
#pragma unroll
    for (int j = 0; j < 4; ++j) { const int n = (lane >> 3) + 8 * j; const LAS float* s = scr + (8 * c) * 33 + n;
        u32x4 o; o.x = pk_bf16(s[0 * 33], s[1 * 33]); o.y = pk_bf16(s[2 * 33], s[3 * 33]); o.z = pk_bf16(s[4 * 33], s[5 * 33]); o.w = pk_bf16(s[6 * 33], s[7 * 33]);
        *(u32x4*)(WT + (size_t)(UZMAP ? uz_row(n0 + n) : n0 + n) * K + k0 + 8 * c) = o; }
    asm volatile("s_waitcnt lgkmcnt(0)" ::: "memory");
}

DI void rms_row(const float* src, const float* g, bf16_t* dstb, float* hcopy, float* outf, int lane) {
    f32x4 v[4]; float s = 0.f;
#pragma unroll
    for (int j = 0; j < 4; ++j) { v[j] = src ? ((const f32x4*)src)[lane + 64 * j] : (f32x4){0.f, 0.f, 0.f, 0.f}; s += (v[j][0] * v[j][0] + v[j][1] * v[j][1]) + (v[j][2] * v[j][2] + v[j][3] * v[j][3]); }
    const float rs = 1.0f / sqrtf(wave_sum(s) * (1.0f / 1024.0f) + EPS);
#pragma unroll
    for (int j = 0; j < 4; ++j) { const f32x4 gv = ((const f32x4*)g)[lane + 64 * j]; const f32x4 y = v[j] * rs * gv;
        if (hcopy) ((f32x4*)hcopy)[lane + 64 * j] = v[j];
        if (outf) ((f32x4*)outf)[lane + 64 * j] = y;
        if (dstb) { u32x2 w; w.x = pk_bf16(y[0], y[1]); w.y = pk_bf16(y[2], y[3]); ((u32x2*)dstb)[lane + 64 * j] = w; } }
}

constexpr int SC_QD = 0, SC_KD = 17408, SC_VI = 34816, SC_ATT = 69632, SC_BB = 78848, SC_ER = 112640, SC_EL = 113152, SC_RR = 113664, SC_TOT = 114176, SC_DS = 116224, SC_MISC = 116736;
constexpr int ATT_STRIDE = 144, OT_STRIDE = 528, VIMG = 17408, BBS = 132;
constexpr int NSEG = 4, CPS = (SEQ / 64) / NSEG;

DI bf16x8 tr_frag2(LAS unsigned char* p) {
    const s16x4 a = __builtin_amdgcn_ds_read_tr16_b64_v4i16((LAS s16x4*)p);
    const s16x4 b = __builtin_amdgcn_ds_read_tr16_b64_v4i16((LAS s16x4*)(p + 4 * TS));
    return (bf16x8){a[0], a[1], a[2], a[3], b[0], b[1], b[2], b[3]};
}

template <int MODE>
DI void scan_prompt(LAS unsigned char* lds, const int w, const int bh, const int seg, const bf16_t* Q, const f16_t* LOGF, const bf16_t* V, const bf16_t* Z, bf16_t* A2, const float* gn, float* Sout,
                    float* SL, float* DSEG) {
    const int lane = lane_id_v(), tid = w * 64 + lane, fr = lane & 15, fq = lane >> 4;
    const int b = bh >> 3, h = bh & 7;
    const int lt = tid >> 3, lg = tid & 7;
    const size_t row_base = (size_t)b * SEQ + (size_t)seg * CPS * 64;
    const size_t hm_base = (size_t)bh * SEQ + (size_t)seg * CPS * 64;
    LAS float* BB = (LAS float*)(lds + SC_BB); LAS float* ER = (LAS float*)(lds + SC_ER); LAS float* EL = (LAS float*)(lds + SC_EL); LAS float* RR = (LAS float*)(lds + SC_RR);
    LAS float* TOT = (LAS float*)(lds + SC_TOT); LAS float* DS = (LAS float*)(lds + SC_DS);
    LAS unsigned char* rb16 = lds + fr * TS + fq * 16;
    LAS unsigned char* rb8 = lds + fr * TS + fq * 8;
    LAS unsigned char* trb = lds + (8 * fq + ((lane & 15) >> 2)) * TS + (lane & 3) * 8;
    LAS unsigned char* atb = lds + SC_ATT + fr * ATT_STRIDE + fq * 16;
    f32x4 Sacc[8][2];
#pragma unroll
    for (int mb = 0; mb < 8; ++mb) { Sacc[mb][0] = (f32x4){0.f, 0.f, 0.f, 0.f}; Sacc[mb][1] = (f32x4){0.f, 0.f, 0.f, 0.f}; }
    if (MODE == 0) {
        f32x4 coef[8];
#pragma unroll
        for (int mb = 0; mb < 8; ++mb) coef[mb] = (f32x4){1.f, 1.f, 1.f, 1.f};
        for (int sp = seg - 1; sp >= 0; --sp) {
            const float* sl = SL + ((size_t)bh * (NSEG - 1) + sp) * 128 * 256 + tid;
            float t[64];
#pragma unroll
            for (int idx = 0; idx < 64; ++idx) t[idx] = __builtin_nontemporal_load(sl + (size_t)idx * 512);
#pragma unroll
            for (int mb = 0; mb < 8; ++mb)
#pragma unroll
                for (int nt = 0; nt < 2; ++nt)
#pragma unroll
                    for (int jj = 0; jj < 4; ++jj) Sacc[mb][nt][jj] += coef[mb][jj] * t[(mb * 2 + nt) * 4 + jj];
            if (sp > 0) { const float* dd = DSEG + ((size_t)bh * (NSEG - 1) + sp) * 128;
#pragma unroll
                for (int mb = 0; mb < 8; ++mb) { f32x4 e4 = *(const f32x4*)(dd + 16 * mb + 4 * fq);
                    e4[0] = __expf(e4[0]); e4[1] = __expf(e4[1]); e4[2] = __expf(e4[2]); e4[3] = __expf(e4[3]); coef[mb] *= e4; } }
        }
    } else { if (tid < 128) DS[tid] = 0.f; }
    EL[tid & 127] = 1.0f;
    if (MODE == 0) { if (tid < 256) ((LAS float*)(lds + SC_MISC))[tid] = gn[tid]; }
    u32x4 rq[2]; u32x4 rl[2]; u32x4 rv[4];
    {
        const size_t row = hm_base + lt;
        if (MODE == 0) { const u32x4* qp = (const u32x4*)(Q + row * 128 + 16 * lg); rq[0] = qp[0]; rq[1] = qp[1]; }
        const u32x4* lp = (const u32x4*)(LOGF + row * 128 + 16 * lg);
#pragma unroll
        for (int i = 0; i < 2; ++i) rl[i] = lp[i];
        const u32x4* vp = (const u32x4*)(V + row * 256 + 32 * lg);
#pragma unroll
        for (int i = 0; i < 4; ++i) rv[i] = vp[i];
    }
#pragma unroll 1
    for (int c = 0; c < CPS; ++c) {
        unsigned kkp[8];
#pragma unroll
        for (int i = 0; i < 4; ++i) { const unsigned p0 = rl[i >> 1][2 * (i & 1)], p1 = rl[i >> 1][2 * (i & 1) + 1];
            const f32x4 lf = (f32x4){f16_lo(p0), f16_hi(p0), f16_lo(p1), f16_hi(p1)};
            *(LAS f32x4*)(BB + lt * BBS + 16 * lg + 4 * i) = lf;
            kkp[2 * i] = pk_bf16(1.0f - __expf(lf[0]), 1.0f - __expf(lf[1])); kkp[2 * i + 1] = pk_bf16(1.0f - __expf(lf[2]), 1.0f - __expf(lf[3])); }
#pragma unroll
        for (int i = 0; i < 4; ++i) *(LAS u32x4*)(lds + SC_VI + (lg >> 2) * VIMG + lt * TS + (4 * (lg & 3) + i) * 16) = rv[i];
        __syncthreads();
        {
            const int sg = w >> 1, k = tid & 127; float run[16]; float s = 0.f;
#pragma unroll
            for (int i = 0; i < 16; ++i) { s += BB[(16 * sg + i) * BBS + k]; run[i] = s; }
            TOT[sg * 128 + k] = s;
            __syncthreads();
            const float t0 = TOT[k], t1 = TOT[128 + k], t2 = TOT[256 + k];
            const float off = (sg > 0 ? t0 : 0.f) + (sg > 1 ? t1 : 0.f) + (sg > 2 ? t2 : 0.f);
#pragma unroll
            for (int i = 0; i < 16; ++i) BB[(16 * sg + i) * BBS + k] = run[i] + off;
            if (sg == 3) { const float r = t0 + t1, bl = off + run[15]; RR[k] = r; ER[k] = EL[k] * __expf(r); EL[k] = __expf(bl - r); if (MODE == 1) DS[k] += bl; }
            __syncthreads();
        }
        {
#pragma unroll
            for (int hh = 0; hh < 2; ++hh) {
                const f32x4 b0 = *(LAS f32x4*)(BB + lt * BBS + 16 * lg + 8 * hh), b1 = *(LAS f32x4*)(BB + lt * BBS + 16 * lg + 8 * hh + 4);
                const f32x4 r0 = *(LAS f32x4*)(RR + 16 * lg + 8 * hh), r1 = *(LAS f32x4*)(RR + 16 * lg + 8 * hh + 4);
                const f32x4 d0 = b0 - r0, d1 = b1 - r1;
                u32x4 ko;
                if (MODE == 0) { u32x4 qo;
                    qo.x = pk_bf16(bf_lo(rq[hh].x) * __expf(d0[0]), bf_hi(rq[hh].x) * __expf(d0[1])); qo.y = pk_bf16(bf_lo(rq[hh].y) * __expf(d0[2]), bf_hi(rq[hh].y) * __expf(d0[3]));
                    qo.z = pk_bf16(bf_lo(rq[hh].z) * __expf(d1[0]), bf_hi(rq[hh].z) * __expf(d1[1])); qo.w = pk_bf16(bf_lo(rq[hh].w) * __expf(d1[2]), bf_hi(rq[hh].w) * __expf(d1[3]));
                    *(LAS u32x4*)(lds + SC_QD + lt * TS + (2 * lg + hh) * 16) = qo; }
                ko.x = pk_bf16(bf_lo(kkp[4 * hh]) * __expf(-d0[0]), bf_hi(kkp[4 * hh]) * __expf(-d0[1])); ko.y = pk_bf16(bf_lo(kkp[4 * hh + 1]) * __expf(-d0[2]), bf_hi(kkp[4 * hh + 1]) * __expf(-d0[3]));
                ko.z = pk_bf16(bf_lo(kkp[4 * hh + 2]) * __expf(-d1[0]), bf_hi(kkp[4 * hh + 2]) * __expf(-d1[1])); ko.w = pk_bf16(bf_lo(kkp[4 * hh + 3]) * __expf(-d1[2]), bf_hi(kkp[4 * hh + 3]) * __expf(-d1[3]));
                *(LAS u32x4*)(lds + SC_KD + lt * TS + (2 * lg + hh) * 16) = ko;
            }
        }
        if (MODE == 1) {
        if (c + 1 < CPS) {
            const size_t row = hm_base + (size_t)(c + 1) * 64 + lt;
            if (MODE == 0) { const u32x4* qp = (const u32x4*)(Q + row * 128 + 16 * lg); rq[0] = qp[0]; rq[1] = qp[1]; }
            const u32x4* lp = (const u32x4*)(LOGF + row * 128 + 16 * lg);
#pragma unroll
            for (int i = 0; i < 2; ++i) rl[i] = lp[i];
            const u32x4* vp = (const u32x4*)(V + row * 256 + 32 * lg);
#pragma unroll
            for (int i = 0; i < 4; ++i) rv[i] = vp[i];
        }
        }
        __syncthreads();
        if (MODE == 0) {
            const int mt = w >> 1;
#pragma unroll
            for (int q2 = 0; q2 < 2; ++q2) {
                const int ntp = 2 * (w & 1) + q2;
                f32x4 a4 = (f32x4){0.f, 0.f, 0.f, 0.f};
                if (ntp <= mt) {
#pragma unroll
                    for (int ks = 0; ks < 4; ++ks) {
                        const bf16x8 a = *(LAS bf16x8*)(rb16 + SC_QD + mt * 16 * TS + ks * 64);
                        const bf16x8 bq = *(LAS bf16x8*)(rb16 + SC_KD + ntp * 16 * TS + ks * 64);
                        a4 = mfma16(a, bq, a4);
                    }
                }
#pragma unroll
                for (int jj = 0; jj < 4; ++jj) { const int t = 16 * mt + 4 * fq + jj, s = 16 * ntp + fr; const float val = (s <= t) ? a4[jj] : 0.f;
                    *(LAS bf16_t*)(lds + SC_ATT + t * ATT_STRIDE + s * 2) = (bf16_t)(pk_bf16(val, 0.f) & 0xffffu); }
            }
        }
#pragma unroll
        for (int mb = 0; mb < 8; ++mb) { const f32x4 e4 = *(LAS f32x4*)(ER + 16 * mb + 4 * fq); Sacc[mb][0] *= e4; Sacc[mb][1] *= e4; }
        u32x4 zr[4];
        if (MODE == 0) {
            const u32x4* zp = (const u32x4*)(Z + (hm_base + (size_t)c * 64 + lt) * 256 + 32 * lg);
#pragma unroll
            for (int i = 0; i < 4; ++i) zr[i] = zp[i];
            __syncthreads();
        }
        {
            bf16x8 Vf[2][2];
            LAS unsigned char* vtr = trb + SC_VI + (w >> 2) * VIMG + (w & 3) * 64;
#pragma unroll
            for (int ks = 0; ks < 2; ++ks)
#pragma unroll
                for (int nt = 0; nt < 2; ++nt) Vf[ks][nt] = tr_frag2(vtr + ks * 32 * TS + nt * 32);
            if (MODE == 0) {
                f32x4 Oacc[4][2];
#pragma unroll
                for (int mt = 0; mt < 4; ++mt) { Oacc[mt][0] = (f32x4){0.f, 0.f, 0.f, 0.f}; Oacc[mt][1] = (f32x4){0.f, 0.f, 0.f, 0.f}; }
#pragma unroll
                for (int kb = 0; kb < 4; ++kb) {
                    bf16x8 Bf[2];
#pragma unroll
                    for (int nt = 0; nt < 2; ++nt) { u32x4 p; p.x = pk_bf16(Sacc[2 * kb][nt][0], Sacc[2 * kb][nt][1]); p.y = pk_bf16(Sacc[2 * kb][nt][2], Sacc[2 * kb][nt][3]);
                        p.z = pk_bf16(Sacc[2 * kb + 1][nt][0], Sacc[2 * kb + 1][nt][1]); p.w = pk_bf16(Sacc[2 * kb + 1][nt][2], Sacc[2 * kb + 1][nt][3]); Bf[nt] = __builtin_bit_cast(bf16x8, p); }
#pragma unroll
                    for (int mt = 0; mt < 4; ++mt) {
                        const u32x2 lo = *(LAS u32x2*)(rb8 + SC_QD + mt * 16 * TS + kb * 64);
                        const u32x2 hi = *(LAS u32x2*)(rb8 + SC_QD + mt * 16 * TS + kb * 64 + 32);
                        const bf16x8 a = __builtin_bit_cast(bf16x8, (u32x4){lo.x, lo.y, hi.x, hi.y});
                        Oacc[mt][0] = mfma16(a, Bf[0], Oacc[mt][0]); Oacc[mt][1] = mfma16(a, Bf[1], Oacc[mt][1]);
                    }
                }
#pragma unroll
                for (int ks = 0; ks < 2; ++ks)
#pragma unroll
                    for (int mt = 0; mt < 4; ++mt) {
                        const bf16x8 a = *(LAS bf16x8*)(atb + mt * 16 * ATT_STRIDE + ks * 64);
                        Oacc[mt][0] = mfma16(a, Vf[ks][0], Oacc[mt][0]); Oacc[mt][1] = mfma16(a, Vf[ks][1], Oacc[mt][1]);
                    }
                LAS unsigned char* OT = lds + SC_BB;
#pragma unroll
                for (int mt = 0; mt < 4; ++mt)
#pragma unroll
                    for (int jj = 0; jj < 4; ++jj) { const int t = 16 * mt + 4 * fq + jj;
                        *(LAS bf16_t*)(OT + t * OT_STRIDE + (32 * w + fr) * 2) = (bf16_t)(pk_bf16(Oacc[mt][0][jj], 0.f) & 0xffffu);
                        *(LAS bf16_t*)(OT + t * OT_STRIDE + (32 * w + 16 + fr) * 2) = (bf16_t)(pk_bf16(Oacc[mt][1][jj], 0.f) & 0xffffu); }
            }
#pragma unroll
            for (int mb = 0; mb < 8; ++mb)
#pragma unroll
                for (int ks = 0; ks < 2; ++ks) {
                    const bf16x8 a = tr_frag2(trb + SC_KD + ks * 32 * TS + mb * 32);
                    Sacc[mb][0] = mfma16(a, Vf[ks][0], Sacc[mb][0]); Sacc[mb][1] = mfma16(a, Vf[ks][1], Sacc[mb][1]);
                }
        }
        __syncthreads();
        if (MODE == 0) {
            LAS unsigned char* OT = lds + SC_BB; LAS float* GN = (LAS float*)(lds + SC_MISC);
            u32x4 o8[4]; float ssq = 0.f;
#pragma unroll
            for (int i = 0; i < 4; ++i) { o8[i] = *(LAS u32x4*)(OT + lt * OT_STRIDE + (32 * lg + 8 * i) * 2);
#pragma unroll
                for (int e = 0; e < 4; ++e) { const float a = bf_lo(o8[i][e]), c2 = bf_hi(o8[i][e]); ssq += a * a + c2 * c2; } }
            ssq += __shfl_xor(ssq, 1); ssq += __shfl_xor(ssq, 2); ssq += __shfl_xor(ssq, 4);
            const float rs = 1.0f / sqrtf(ssq * (1.0f / 256.0f) + EPS);
            u32x4* op = (u32x4*)(A2 + (row_base + (size_t)c * 64 + lt) * 2048 + 256 * h + 32 * lg);
#pragma unroll
            for (int i = 0; i < 4; ++i) { const f32x4 g0 = *(LAS f32x4*)(GN + 32 * lg + 8 * i), g1 = *(LAS f32x4*)(GN + 32 * lg + 8 * i + 4); u32x4 r;
                r.x = pk_bf16(bf_lo(o8[i].x) * rs * g0[0] * bf_lo(zr[i].x), bf_hi(o8[i].x) * rs * g0[1] * bf_hi(zr[i].x));
                r.y = pk_bf16(bf_lo(o8[i].y) * rs * g0[2] * bf_lo(zr[i].y), bf_hi(o8[i].y) * rs * g0[3] * bf_hi(zr[i].y));
                r.z = pk_bf16(bf_lo(o8[i].z) * rs * g1[0] * bf_lo(zr[i].z), bf_hi(o8[i].z) * rs * g1[1] * bf_hi(zr[i].z));
                r.w = pk_bf16(bf_lo(o8[i].w) * rs * g1[2] * bf_lo(zr[i].w), bf_hi(o8[i].w) * rs * g1[3] * bf_hi(zr[i].w));
                op[i] = r; }
            if (c + 1 < CPS) {
                const size_t row = hm_base + (size_t)(c + 1) * 64 + lt;
                if (MODE == 0) { const u32x4* qp = (const u32x4*)(Q + row * 128 + 16 * lg); rq[0] = qp[0]; rq[1] = qp[1]; }
                const u32x4* lp = (const u32x4*)(LOGF + row * 128 + 16 * lg);
#pragma unroll
                for (int i = 0; i < 2; ++i) rl[i] = lp[i];
                const u32x4* vp = (const u32x4*)(V + row * 256 + 32 * lg);
#pragma unroll
                for (int i = 0; i < 4; ++i) rv[i] = vp[i];
            }
            __syncthreads();
        }
    }
#pragma unroll
    for (int mb = 0; mb < 8; ++mb) { const f32x4 e4 = *(LAS f32x4*)(EL + 16 * mb + 4 * fq); Sacc[mb][0] *= e4; Sacc[mb][1] *= e4; }
    if (MODE == 1) {
        float* sl = SL + ((size_t)bh * (NSEG - 1) + seg) * 128 * 256 + tid;
#pragma unroll
        for (int mb = 0; mb < 8; ++mb)
#pragma unroll
            for (int nt = 0; nt < 2; ++nt)
#pragma unroll
                for (int jj = 0; jj < 4; ++jj) sl[(size_t)((mb * 2 + nt) * 4 + jj) * 512] = Sacc[mb][nt][jj];
        if (tid < 128) DSEG[((size_t)bh * (NSEG - 1) + seg) * 128 + tid] = DS[tid];
        __syncthreads();
    } else if (seg == NSEG - 1) {
        float* so = Sout + (size_t)bh * 128 * 256;
#pragma unroll
        for (int mb = 0; mb < 8; ++mb)
#pragma unroll
            for (int nt = 0; nt < 2; ++nt)
#pragma unroll
                for (int jj = 0; jj < 4; ++jj) so[(size_t)(16 * mb + 4 * fq + jj) * 256 + 32 * w + 16 * nt + fr] = Sacc[mb][nt][jj];
    }
    if (MODE == 0) __syncthreads();
}

DI void scan_sample(LAS unsigned char* lds, const int w, int item, const bf16_t* Q, const f16_t* LOGF, const bf16_t* V, const bf16_t* Z, bf16_t* A2, const float* gn, const float* S0, float* S1) {
    const int lane = lane_id_v(), tid = w * 64 + lane;
    const int b = item >> 3, h = item & 7; const size_t row = (size_t)MP + b;
    LAS float* F = (LAS float*)lds; LAS float* KK = F + 128; LAS float* QQ = F + 256; LAS float* RED = F + 384; LAS float* WS4 = F + 384 + 2048;
    const float* s0 = S0 + (size_t)(b * 8 + h) * 128 * 256; float* s1 = S1 + (size_t)(b * 8 + h) * 128 * 256;
    f32x4 sv[16];
#pragma unroll
    for (int i = 0; i < 16; ++i) sv[i] = __builtin_nontemporal_load((const f32x4*)(s0 + (size_t)(w + 8 * i) * 256) + lane);
    if (tid < 128) { const float lf = (float)__builtin_bit_cast(_Float16, LOGF[row * 1024 + 128 * h + tid]); const float f = __expf(lf); F[tid] = f; KK[tid] = 1.0f - f; QQ[tid] = bf_lo((unsigned)Q[row * 1024 + 128 * h + tid]); }
    const u32x2 vv = *(const u32x2*)(V + row * 2048 + 256 * h + 4 * lane);
    const f32x4 v4 = (f32x4){bf_lo(vv.x), bf_hi(vv.x), bf_lo(vv.y), bf_hi(vv.y)};
    __syncthreads();
    f32x4 o = (f32x4){0.f, 0.f, 0.f, 0.f};
#pragma unroll
    for (int i = 0; i < 16; ++i) { const int k = w + 8 * i; const f32x4 sn = sv[i] * F[k] + v4 * KK[k]; o += sn * QQ[k];
        __builtin_nontemporal_store(sn, (f32x4*)(s1 + (size_t)k * 256) + lane); }
    *(LAS f32x4*)(RED + w * 256 + 4 * lane) = o;
    __syncthreads();
    if (tid < 256) { float s = 0.f;
#pragma unroll
        for (int i = 0; i < 8; ++i) s += RED[i * 256 + tid];
        const float p = wave_sum(s * s); if (lane == 0) WS4[w] = p;
        RED[tid] = s; }
    __syncthreads();
    if (tid < 256) { const float ss = WS4[0] + WS4[1] + WS4[2] + WS4[3]; const float rs = 1.0f / sqrtf(ss * (1.0f / 256.0f) + EPS);
        const float zz = bf_lo((unsigned)Z[row * 2048 + 256 * h + tid]);
        A2[row * 2048 + 256 * h + tid] = (bf16_t)(pk_bf16(RED[tid] * rs * gn[tid] * zz, 0.f) & 0xffffu); }
    __syncthreads();
}

DI void ln_row(bf16_t* gv, const float* g, const float* bta, float* outf, int lane) {
    u32x4 x[4]; float s = 0.f;
#pragma unroll
    for (int i = 0; i < 4; ++i) { x[i] = ((const u32x4*)gv)[lane + 64 * i];
#pragma unroll
        for (int e = 0; e < 4; ++e) s += bf_lo(x[i][e]) + bf_hi(x[i][e]); }
    const float mu = wave_sum(s) * (1.0f / 2048.0f); float q = 0.f;
#pragma unroll
    for (int i = 0; i < 4; ++i)
#pragma unroll
        for (int e = 0; e < 4; ++e) { const float a = bf_lo(x[i][e]) - mu, c = bf_hi(x[i][e]) - mu; q += a * a + c * c; }
    const float rstd = 1.0f / sqrtf(wave_sum(q) * (1.0f / 2048.0f) + EPS);
#pragma unroll
    for (int i = 0; i < 4; ++i) { const int c0 = 8 * (lane + 64 * i);
        const f32x4 g0 = *(const f32x4*)(g + c0), g1 = *(const f32x4*)(g + c0 + 4), b0 = *(const f32x4*)(bta + c0), b1 = *(const f32x4*)(bta + c0 + 4);
        f32x4 y0, y1;
        y0[0] = (bf_lo(x[i][0]) - mu) * rstd * g0[0] + b0[0]; y0[1] = (bf_hi(x[i][0]) - mu) * rstd * g0[1] + b0[1];
        y0[2] = (bf_lo(x[i][1]) - mu) * rstd * g0[2] + b0[2]; y0[3] = (bf_hi(x[i][1]) - mu) * rstd * g0[3] + b0[3];
        y1[0] = (bf_lo(x[i][2]) - mu) * rstd * g1[0] + b1[0]; y1[1] = (bf_hi(x[i][2]) - mu) * rstd * g1[1] + b1[1];
        y1[2] = (bf_lo(x[i][3]) - mu) * rstd * g1[2] + b1[2]; y1[3] = (bf_hi(x[i][3]) - mu) * rstd * g1[3] + b1[3];
        u32x4 o; o.x = pk_bf16(y0[0], y0[1]); o.y = pk_bf16(y0[2], y0[3]); o.z = pk_bf16(y1[0], y1[1]); o.w = pk_bf16(y1[2], y1[3]);
        ((u32x4*)gv)[lane + 64 * i] = o;
        if (outf) { *(f32x4*)(outf + c0) = y0; *(f32x4*)(outf + c0 + 4) = y1; } }
}

DI void ln_gate_sample_row(const bf16_t* gv, const bf16_t* uzrow, bf16_t* a2row, const float* g, const float* bta, const float* wsp, const float* bsp, float* outf, int lane) {
    u32x4 x[4]; float s = 0.f;
#pragma unroll
    for (int i = 0; i < 4; ++i) { x[i] = ((const u32x4*)gv)[lane + 64 * i];
#pragma unroll
        for (int e = 0; e < 4; ++e) s += bf_lo(x[i][e]) + bf_hi(x[i][e]); }
    const float mu = wave_sum(s) * (1.0f / 2048.0f); float q = 0.f;
#pragma unroll
    for (int i = 0; i < 4; ++i)
#pragma unroll
        for (int e = 0; e < 4; ++e) { const float a = bf_lo(x[i][e]) - mu, c = bf_hi(x[i][e]) - mu; q += a * a + c * c; }
    const float rstd = 1.0f / sqrtf(wave_sum(q) * (1.0f / 2048.0f) + EPS);
#pragma unroll
    for (int i = 0; i < 4; ++i) { const int c0 = 8 * (lane + 64 * i), grp = c0 >> 8; const float w00 = wsp[(size_t)grp * 128 * 128], b0s = bsp[grp * 128];
        const f32x4 g0 = *(const f32x4*)(g + c0), g1 = *(const f32x4*)(g + c0 + 4), b0 = *(const f32x4*)(bta + c0), b1 = *(const f32x4*)(bta + c0 + 4);
        f32x4 y0, y1;
        y0[0] = (bf_lo(x[i][0]) - mu) * rstd * g0[0] + b0[0]; y0[1] = (bf_hi(x[i][0]) - mu) * rstd * g0[1] + b0[1];
        y0[2] = (bf_lo(x[i][1]) - mu) * rstd * g0[2] + b0[2]; y0[3] = (bf_hi(x[i][1]) - mu) * rstd * g0[3] + b0[3];
        y1[0] = (bf_lo(x[i][2]) - mu) * rstd * g1[0] + b1[0]; y1[1] = (bf_hi(x[i][2]) - mu) * rstd * g1[1] + b1[1];
        y1[2] = (bf_lo(x[i][3]) - mu) * rstd * g1[2] + b1[2]; y1[3] = (bf_hi(x[i][3]) - mu) * rstd * g1[3] + b1[3];
        *(f32x4*)(outf + c0) = y0; *(f32x4*)(outf + c0 + 4) = y1;
        const u32x4 uz = *(const u32x4*)(uzrow + c0); u32x4 o;
        o.x = pk_bf16(bf_lo(uz.x) * (w00 * y0[0] + b0s), bf_hi(uz.x) * (w00 * y0[1] + b0s));
        o.y = pk_bf16(bf_lo(uz.y) * (w00 * y0[2] + b0s), bf_hi(uz.y) * (w00 * y0[3] + b0s));
        o.z = pk_bf16(bf_lo(uz.z) * (w00 * y1[0] + b0s), bf_hi(uz.z) * (w00 * y1[1] + b0s));
        o.w = pk_bf16(bf_lo(uz.w) * (w00 * y1[2] + b0s), bf_hi(uz.w) * (w00 * y1[3] + b0s));
        *(u32x4*)(a2row + c0) = o; }
}

constexpr int SP_WI = 0, SP_VI = 34816, SP_VIMG = 34816, SP_MU = 106496;
DI void spatial_item(LAS unsigned char* lds, const int w, int item, const float* Wsp, const float* bsp, const bf16_t* VN, const bf16_t* UZ, bf16_t* A2,
                     const float* LNST, const float* lng, const float* lnb, float* cvp  ) {
    const int lane = lane_id_v(), tid = w * 64 + lane, fr = lane & 15, fq = lane >> 4;
    const int g = item & 7, n = (item >> 3) & 15, b = item >> 7;
    const size_t row_base = (size_t)b * SEQ + (size_t)n * 128;
    LAS float* MU = (LAS float*)(lds + SP_MU);
    if (tid < 128) {
        const f32x4* p = (const f32x4*)(LNST + (row_base + tid) * 64); f32x4 t = p[0];
#pragma unroll
        for (int i = 1; i < 16; ++i) t += p[i];
        const float mu = (t[0] + t[2]) * (1.0f / 2048.0f), var = fmaxf((t[1] + t[3]) * (1.0f / 2048.0f) - mu * mu, 0.f);
        MU[tid] = mu; MU[128 + tid] = 1.0f / sqrtf(var + EPS);
    }
    __syncthreads();
    {
        const float* wg = Wsp + (size_t)g * 128 * 128;
#pragma unroll
        for (int i = 0; i < 4; ++i) { const int ci = tid + 512 * i, t = ci >> 4, ch = ci & 15;
            const f32x4 a = *(const f32x4*)(wg + t * 128 + 8 * ch), c = *(const f32x4*)(wg + t * 128 + 8 * ch + 4); const int s0 = 8 * ch;
            u32x4 o; o.x = pk_bf16(s0 + 0 <= t ? a[0] : 0.f, s0 + 1 <= t ? a[1] : 0.f); o.y = pk_bf16(s0 + 2 <= t ? a[2] : 0.f, s0 + 3 <= t ? a[3] : 0.f);
            o.z = pk_bf16(s0 + 4 <= t ? c[0] : 0.f, s0 + 5 <= t ? c[1] : 0.f); o.w = pk_bf16(s0 + 6 <= t ? c[2] : 0.f, s0 + 7 <= t ? c[3] : 0.f);
            *(LAS u32x4*)(lds + SP_WI + t * TS + ch * 16) = o; }
        const int c32 = tid & 31, cc = 256 * g + 8 * c32;
        const f32x4 g0 = *(const f32x4*)(lng + cc), g1 = *(const f32x4*)(lng + cc + 4), b0 = *(const f32x4*)(lnb + cc), b1 = *(const f32x4*)(lnb + cc + 4);
#pragma unroll
        for (int i = 0; i < 8; ++i) { const int s = (tid >> 5) + 16 * i;
            const u32x4 x = *(const u32x4*)(VN + (row_base + s) * 2048 + cc);
            const float mu = MU[s], rstd = MU[128 + s]; f32x4 y0, y1;
            y0[0] = (bf_lo(x.x) - mu) * rstd * g0[0] + b0[0]; y0[1] = (bf_hi(x.x) - mu) * rstd * g0[1] + b0[1]; y0[2] = (bf_lo(x.y) - mu) * rstd * g0[2] + b0[2]; y0[3] = (bf_hi(x.y) - mu) * rstd * g0[3] + b0[3];
            y1[0] = (bf_lo(x.z) - mu) * rstd * g1[0] + b1[0]; y1[1] = (bf_hi(x.z) - mu) * rstd * g1[1] + b1[1]; y1[2] = (bf_lo(x.w) - mu) * rstd * g1[2] + b1[2]; y1[3] = (bf_hi(x.w) - mu) * rstd * g1[3] + b1[3];
            if (n == 15) { float* o = cvp + ((size_t)b * 128 + s) * 2048 + cc; *(f32x4*)o = y0; *(f32x4*)(o + 4) = y1; }
            u32x4 o; o.x = pk_bf16(y0[0], y0[1]); o.y = pk_bf16(y0[2], y0[3]); o.z = pk_bf16(y1[0], y1[1]); o.w = pk_bf16(y1[2], y1[3]);
            *(LAS u32x4*)(lds + SP_VI + (c32 >> 4) * SP_VIMG + s * TS + (c32 & 15) * 16) = o; }
    }
    __syncthreads();
    f32x4 acc[8][2];
#pragma unroll
    for (int mt = 0; mt < 8; ++mt) { acc[mt][0] = (f32x4){0.f, 0.f, 0.f, 0.f}; acc[mt][1] = (f32x4){0.f, 0.f, 0.f, 0.f}; }
    LAS unsigned char* vtr = lds + SP_VI + (w >> 2) * SP_VIMG + (w & 3) * 64 + (8 * fq + ((lane & 15) >> 2)) * TS + (lane & 3) * 8;
    LAS unsigned char* wrb = lds + SP_WI + fr * TS + fq * 16;
#pragma unroll
    for (int ks = 0; ks < 4; ++ks) {
        const bf16x8 v0 = tr_frag2(vtr + ks * 32 * TS), v1 = tr_frag2(vtr + ks * 32 * TS + 32);
#pragma unroll
        for (int mt = 0; mt < 8; ++mt) {
            if (32 * ks > 16 * mt + 15) continue;
            const bf16x8 wf = *(LAS bf16x8*)(wrb + mt * 16 * TS + ks * 64);
            acc[mt][0] = mfma16(v0, wf, acc[mt][0]); acc[mt][1] = mfma16(v1, wf, acc[mt][1]);
        }
    }
    __syncthreads();
    {
        constexpr int SS = 528;
        const float* bg = bsp + g * 128;
#pragma unroll
        for (int mt = 0; mt < 8; ++mt) { const int t = 16 * mt + fr; const float bs = bg[t];
#pragma unroll
            for (int nt = 0; nt < 2; ++nt) { const f32x4 a = acc[mt][nt]; u32x2 o; o.x = pk_bf16(a[0] + bs, a[1] + bs); o.y = pk_bf16(a[2] + bs, a[3] + bs);
                *(LAS u32x2*)(lds + t * SS + (32 * w + 16 * nt + 4 * fq) * 2) = o; } }
        __syncthreads();
#pragma unroll
        for (int i = 0; i < 2; ++i) { const int task = tid + 512 * i, t = task >> 3, cg8 = task & 7;
            const size_t ro = (row_base + t) * 2048 + 256 * g + 32 * cg8;
            const u32x4* up = (const u32x4*)(UZ + ro); u32x4* op = (u32x4*)(A2 + ro);
#pragma unroll
            for (int q = 0; q < 4; ++q) { const u32x4 sv = *(LAS u32x4*)(lds + t * SS + (32 * cg8 + 8 * q) * 2); const u32x4 uu = up[q]; u32x4 o;
#pragma unroll
                for (int e = 0; e < 4; ++e) o[e] = pk_bf16(bf_lo(uu[e]) * bf_lo(sv[e]), bf_hi(uu[e]) * bf_hi(sv[e]));
                op[q] = o; } }
    }
    __syncthreads();
}

#define XB_TMO      128
#define XB_XCNT(j)  (256  + 64 * (j))
#define XB_XSUB(j)  (1280 + 64 * (j))
#define XB_XGEN(j)  (2304 + 64 * (j))
#define XB_TOP      3328
#define XB_TOPGEN   3392
#define XCD_BAR_WORDS 3456
#define XB_SPIN_CAP (1u << 18)
DI unsigned xb_ld(unsigned* p)              { return __hip_atomic_load(p, __ATOMIC_RELAXED, __HIP_MEMORY_SCOPE_AGENT); }
DI unsigned xb_add(unsigned* p, unsigned v) { return __hip_atomic_fetch_add(p, v, __ATOMIC_RELAXED, __HIP_MEMORY_SCOPE_AGENT); }
DI unsigned xb_xcc_id() { return (unsigned)__builtin_amdgcn_s_getreg((3 << 11) | 20) & 0xFu; }
#define XB_SPIN(cond, bar) do { unsigned _sp = 0; while (cond) { __builtin_amdgcn_s_sleep(1); \
    if ((++_sp & 255u) == 0u) { if (xb_ld(&(bar)[XB_TMO])) break; if (_sp > XB_SPIN_CAP) { atomicAdd(&(bar)[XB_TMO], 1u); break; } } } } while (0)
struct XcdBarrier { unsigned* bar; unsigned x; volatile LAS unsigned* st; };
DI XcdBarrier xcd_barrier_post(unsigned* bar, volatile LAS unsigned* st, bool leader) {
    XcdBarrier b; b.bar = bar; b.x = xb_xcc_id(); b.st = st;
    if (leader) (void)xb_add(&bar[XB_XCNT(b.x)], 1u);
    return b;
}
DI void xcd_barrier_complete(unsigned* bar, unsigned x, unsigned& nloc, unsigned& nx) {
    const unsigned G = gridDim.x * gridDim.y * gridDim.z;
    unsigned sum, cnt, mine, sp = 0u;
    for (;;) {
        sum = 0u; cnt = 0u; mine = 0u;
#pragma unroll
        for (unsigned j = 0; j < 16; ++j) { const unsigned c = xb_ld(&bar[XB_XCNT(j)]); sum += c; cnt += (c > 0u) ? 1u : 0u; mine = (j == x) ? c : mine; }
        if (sum == G) break;
        __builtin_amdgcn_s_sleep(1);
        if ((++sp & 255u) == 0u) { if (xb_ld(&bar[XB_TMO])) break; if (sp > XB_SPIN_CAP) { atomicAdd(&bar[XB_TMO], 1u); break; } }
    }
    nloc = mine > 0u ? mine : 1u; nx = cnt > 0u ? cnt : 1u;
}
DI void xcd_barrier(const XcdBarrier& b, const int wave) {
    asm volatile("s_waitcnt vmcnt(0)" ::: "memory");
    __syncthreads();
    if (wave == 0 && lane_id_v() == 0) {
        unsigned* bar = b.bar;
        __builtin_amdgcn_s_waitcnt(0);
        unsigned nloc = b.st[0], nx = b.st[1];
        if (nloc == 0u) { xcd_barrier_complete(bar, b.x, nloc, nx); b.st[0] = nloc; b.st[1] = nx; }
        const unsigned old = xb_add(&bar[XB_XSUB(b.x)], 1u);
        const unsigned gen = old / nloc;
        if (old + 1u == (gen + 1u) * nloc) {
            __builtin_amdgcn_fence(__ATOMIC_RELEASE, "agent");
            asm volatile("s_waitcnt vmcnt(0)" ::: "memory");
            const unsigned og = xb_add(&bar[XB_TOP], 1u);
            const unsigned tg = og / nx;
            if (og + 1u == (tg + 1u) * nx) xb_add(&bar[XB_TOPGEN], 1u);
            else XB_SPIN(xb_ld(&bar[XB_TOPGEN]) == tg, bar);
            __builtin_amdgcn_fence(__ATOMIC_ACQUIRE, "agent");
            xb_add(&bar[XB_XGEN(b.x)], 1u);
            asm volatile("s_waitcnt vmcnt(0)" ::: "memory");
        } else {
            XB_SPIN(xb_ld(&bar[XB_XGEN(b.x)]) == gen, bar);
            __builtin_amdgcn_fence(__ATOMIC_ACQUIRE, "agent");
            asm volatile("s_waitcnt vmcnt(0)" ::: "memory");
        }
    }
    __syncthreads();
}

struct Args { const float* in[20]; float* out; unsigned char* ws; int ph_lo, ph_hi; };
constexpr int N_PHASES = 2 + (4 + 4 + 5 + 4) + 1;
#define WSP(T, off) ((T*)(A->ws + (off)))
typedef const __attribute__((address_space(4))) Args KArgs;
DI KArgs* ka_ptr() { KArgs* p = (KArgs*)__builtin_amdgcn_kernarg_segment_ptr(); asm volatile("" : "+s"(p)); return p; }

__global__ void __launch_bounds__(NTHREADS, 2) fwd_kernel(Args args) {
    extern __shared__ __attribute__((aligned(16))) unsigned char lds_raw[];
    LAS unsigned char* lds = (LAS unsigned char*)lds_raw;
    const int wave = __builtin_amdgcn_readfirstlane(threadIdx.x >> 6);
    const int G = gridDim.x, bid = blockIdx.x;
    const int gw = bid * NWAVES + wave, NGW = G * NWAVES;
    const int lo = args.ph_lo, hi = args.ph_hi;

    volatile LAS unsigned* xst = (volatile LAS unsigned*)(lds + LDS_BYTES - 64);
    if (threadIdx.x < 2) xst[threadIdx.x] = 0u;
    __syncthreads();
    (void)xcd_barrier_post((unsigned*)(args.ws + WS_CTR), xst, threadIdx.x == 0);

    int ph = 0;
#define RUN_PHASE (lo <= ph && ph < hi)
#define SEAM() do { if (lo <= ph && ph + 1 < hi) { if (ka_ptr()->ph_lo < 0) cg::this_grid().sync(); else { XcdBarrier xb_; xb_.bar = (unsigned*)(ka_ptr()->ws + WS_CTR); xb_.x = xb_xcc_id(); xb_.st = (volatile LAS unsigned*)(lds + LDS_BYTES - 64); xcd_barrier(xb_, wave); } } ++ph; } while (0)

    if (RUN_PHASE) { KArgs* A = ka_ptr();
        const int lane = lane_id_v();
        LAS float* scr = (LAS float*)(lds + wave * 16384);
        constexpr int I_IN = 16 * 192, I_OUT = 32 * 32, I_G = 16 * 32, I_P = 4 * 32;
        constexpr int NITEMS = 4 * I_IN + 4 * I_OUT + 4 * I_G + 4 * I_P;
        for (int it = gw; it < NITEMS; it += NGW) {
            int r = it;
            if (r < 2 * I_IN) { const int j = r / I_IN; transpose_item(A->in[6] + (size_t)j * 1024 * 6144, 1024, 6144, WSP(bf16_t, WS_WINA) + (size_t)j * 6144 * 1024, scr, r % I_IN, lane, A->in[5] + (2 * j) * 1024); continue; } r -= 2 * I_IN;
            if (r < 2 * I_IN) { const int j = r / I_IN; transpose_item<true>(A->in[10] + (size_t)j * 1024 * 6144, 1024, 6144, WSP(bf16_t, WS_WINB) + (size_t)j * 6144 * 1024, scr, r % I_IN, lane, A->in[5] + (2 * j + 1) * 1024); continue; } r -= 2 * I_IN;
            if (r < 2 * I_OUT) { const int j = r / I_OUT; transpose_item(A->in[9] + (size_t)j * 2048 * 1024, 2048, 1024, WSP(bf16_t, WS_WOUTA) + (size_t)j * 1024 * 2048, scr, r % I_OUT, lane); continue; } r -= 2 * I_OUT;
            if (r < 2 * I_OUT) { const int j = r / I_OUT; transpose_item(A->in[15] + (size_t)j * 2048 * 1024, 2048, 1024, WSP(bf16_t, WS_WOUTB) + (size_t)j * 1024 * 2048, scr, r % I_OUT, lane); continue; } r -= 2 * I_OUT;
            if (r < 4 * I_G) { const int j = r / I_G; transpose_item(A->in[17] + (size_t)j * 1024 * 1024, 1024, 1024, WSP(bf16_t, WS_WG) + (size_t)j * 1024 * 1024, scr, r % I_G, lane, A->in[16] + j * 1024); continue; } r -= 4 * I_G;
            { const int j = r / I_P; transpose_item(A->in[18] + (size_t)j * 256 * 1024, 256, 1024, WSP(bf16_t, WS_WP) + (size_t)j * 1024 * 256, scr, r % I_P, lane); }
        }
        for (int m = gw; m < MR; m += NGW) {
            const float* src = m < MP ? A->in[0] + (size_t)m * 1024 : A->in[1] + (size_t)(m - MP) * 1024;
            float ss = 0.f;
#pragma unroll
            for (int jq = 0; jq < 4; ++jq) { const f32x4 v = ((const f32x4*)src)[lane + 64 * jq]; ss += (v[0] * v[0] + v[1] * v[1]) + (v[2] * v[2] + v[3] * v[3]);
                u32x2 w; w.x = pk_bf16(v[0], v[1]); w.y = pk_bf16(v[2], v[3]); ((u32x2*)(WSP(bf16_t, WS_HB) + (size_t)m * 1024))[lane + 64 * jq] = w; }
            ss = wave_sum(ss);
            const float one = (lane == 0) ? ss : 0.f;
            if (m < MP) { if (lane < 16) WSP(float, WS_SSPB)[(size_t)m * 16 + lane] = one; }
            else WSP(float, WS_SSSB)[(size_t)(m - MP) * 64 + lane] = one;
        }
        for (int idx0 = gw; idx0 < 4 * MPAD; idx0 += 4 * NGW) {
            f32x4 v[4];
#pragma unroll
            for (int q = 0; q < 4; ++q) { const int idx = idx0 + q * NGW; v[q] = (f32x4){0.f, 0.f, 0.f, 0.f};
                if (idx < 4 * MPAD) { const int i = idx / MPAD, m = idx % MPAD;
                    if (m < MP) v[q] = ((const f32x4*)(A->in[3] + ((size_t)i * MP + m) * 256))[lane];
                    else if (m < MR) v[q] = ((const f32x4*)(A->in[4] + ((size_t)i * NSMP + (m - MP)) * 256))[lane]; } }
#pragma unroll
            for (int q = 0; q < 4; ++q) { const int idx = idx0 + q * NGW;
                if (idx < 4 * MPAD) { u32x2 o; o.x = pk_bf16(v[q][0], v[q][1]); o.y = pk_bf16(v[q][2], v[q][3]); ((u32x2*)(WSP(bf16_t, WS_PB) + (size_t)idx * 256))[lane] = o; } }
        }
        if (bid == 0) { const float* lb_logits = A->in[7]; float* LB = WSP(float, WS_LB);
            for (int c = wave * 64 + lane; c < 1024; c += NTHREADS) {
                const float l0 = lb_logits[c], l1 = lb_logits[1024 + c], mx = fmaxf(l0, l1), e0 = expf(l0 - mx), e1 = expf(l1 - mx), s0 = e0 / (e0 + e1), s1 = e1 / (e0 + e1);
                const float c0 = s0, c1 = s0 + s1; LB[c] = c0 - c0; LB[1024 + c] = c1 - c0; } }
    }
    SEAM();
    if (RUN_PHASE) { KArgs* A = ka_ptr();
        { pg8::Gemm g{WSP(bf16_t, WS_PB), WSP(bf16_t, WS_WP), (size_t)MPAD * 256 * 2, (size_t)1024 * 256 * 2}; pg8::Order S; S.init(MP, 1024, 4, G, bid); pg8::EpiPle E{WSP(bf16_t, WS_PLE)}; pg8::gemm_phase<256>(lds, wave, g, S, E);
          TEpiPle TE{WSP(bf16_t, WS_PLE)}; thin_gemm<256, 1, 8>(lds, wave, WSP(bf16_t, WS_PB) + (size_t)MP * 256, (size_t)MPAD * 256, WSP(bf16_t, WS_WP), (size_t)1024 * 256, 1024, 4, bid, G, TE); }
        { pg8::Gemm g{WSP(bf16_t, WS_HB), WSP(bf16_t, WS_WINA), 0, 0}; pg8::Order S; S.init(MP, 6144, 1, G, bid);
          pg8::EpiInA E{WSP(bf16_t, WS_Q), WSP(f16_t, WS_LOGF), WSP(bf16_t, WS_V), WSP(bf16_t, WS_Z), WSP(float, WS_LB), WSP(float, WS_SSPB)}; pg8::gemm_phase<1024>(lds, wave, g, S, E);
          TEpiInA TE{WSP(bf16_t, WS_Q), WSP(f16_t, WS_LOGF), WSP(bf16_t, WS_V), WSP(bf16_t, WS_Z), WSP(float, WS_LB), WSP(float, WS_SSSB)}; thin_gemm<1024, 2, 8>(lds, wave, WSP(bf16_t, WS_HB) + (size_t)MP * 1024, 0, WSP(bf16_t, WS_WINA), 0, 6144, 1, bid, G, TE); }
    }
    SEAM();
#pragma unroll 1
    for (int li = 0; li < 4; ++li) {
        const int j = li >> 1;
        if ((li & 1) == 0) {
            if (li > 0) {
                if (RUN_PHASE) { KArgs* A = ka_ptr(); pg8::Gemm g{WSP(bf16_t, WS_HB), WSP(bf16_t, WS_WINA) + (size_t)j * 6144 * 1024, 0, 0}; pg8::Order S; S.init(MP, 6144, 1, G, bid);
                    pg8::EpiInA E{WSP(bf16_t, WS_Q), WSP(f16_t, WS_LOGF), WSP(bf16_t, WS_V), WSP(bf16_t, WS_Z), WSP(float, WS_LB) + j * 1024, WSP(float, WS_SSPB)}; pg8::gemm_phase<1024>(lds, wave, g, S, E);
                    TEpiInA TE{WSP(bf16_t, WS_Q), WSP(f16_t, WS_LOGF), WSP(bf16_t, WS_V), WSP(bf16_t, WS_Z), WSP(float, WS_LB) + j * 1024, WSP(float, WS_SSSB)}; thin_gemm<1024, 2, 8>(lds, wave, WSP(bf16_t, WS_HB) + (size_t)MP * 1024, 0, WSP(bf16_t, WS_WINA) + (size_t)j * 6144 * 1024, 0, 6144, 1, bid, G, TE); }
                SEAM();
            }
            if (RUN_PHASE) { KArgs* A = ka_ptr();
                const float* gn = A->in[8] + j * 256;
                const float* s0 = A->in[2] + (size_t)j * 128 * 8 * 128 * 256; float* s1 = A->out + OUT_SS + (size_t)j * 128 * 8 * 128 * 256;
                const bf16_t* Qb = WSP(bf16_t, WS_Q); const f16_t* LOGF = WSP(f16_t, WS_LOGF); const bf16_t* Vb = WSP(bf16_t, WS_V); const bf16_t* Zb = WSP(bf16_t, WS_Z); bf16_t* A2 = WSP(bf16_t, WS_A2);
                for (int it = bid; it < 64 * (NSEG - 1); it += G) scan_prompt<1>(lds, wave, it & 63, it >> 6, Qb, LOGF, Vb, Zb, A2, gn, nullptr, WSP(float, WS_SL), WSP(float, WS_DSEG));
                if (G == 256) {
                    if (bid >= 192) for (int it = 4 * (bid - 192); it < 4 * (bid - 192) + 4; ++it) scan_sample(lds, wave, it, Qb, LOGF, Vb, Zb, A2, gn, s0, s1);
                } else for (int it = bid; it < NSMP * 8; it += G) scan_sample(lds, wave, it, Qb, LOGF, Vb, Zb, A2, gn, s0, s1);
            }
            SEAM();
            if (RUN_PHASE) { KArgs* A = ka_ptr();
                const float* gn = A->in[8] + j * 256;
                float* sp_out = A->out + OUT_SP + (size_t)j * 8 * 8 * 128 * 256;
                const bf16_t* Qb = WSP(bf16_t, WS_Q); const f16_t* LOGF = WSP(f16_t, WS_LOGF); const bf16_t* Vb = WSP(bf16_t, WS_V); const bf16_t* Zb = WSP(bf16_t, WS_Z); bf16_t* A2 = WSP(bf16_t, WS_A2);
                for (int it = bid; it < 64 * NSEG; it += G) scan_prompt<0>(lds, wave, it & 63, it >> 6, Qb, LOGF, Vb, Zb, A2, gn, sp_out, WSP(float, WS_SL), WSP(float, WS_DSEG));
                if (G == 256) {
                    const float* s0 = A->in[2] + (size_t)j * 128 * 8 * 128 * 256; float* s1 = A->out + OUT_SS + (size_t)j * 128 * 8 * 128 * 256;
                    for (int it = 256 + 3 * bid; it < 256 + 3 * bid + 3; ++it) scan_sample(lds, wave, it, Qb, LOGF, Vb, Zb, A2, gn, s0, s1);
                }
            }
            SEAM();
        } else {
            if (RUN_PHASE) { KArgs* A = ka_ptr(); pg8::Gemm g{WSP(bf16_t, WS_HB), WSP(bf16_t, WS_WINB) + (size_t)j * 6144 * 1024, 0, 0}; pg8::Order S; S.init(MP, 6144, 1, G, bid);
                pg8::EpiInB E{WSP(bf16_t, WS_U), WSP(bf16_t, WS_V), WSP(float, WS_SSPB), WSP(float, WS_LNST)}; pg8::gemm_phase<1024>(lds, wave, g, S, E);
                TEpiInB TE{WSP(bf16_t, WS_U), WSP(bf16_t, WS_V), WSP(float, WS_SSSB)}; thin_gemm<1024, 2, 8>(lds, wave, WSP(bf16_t, WS_HB) + (size_t)MP * 1024, 0, WSP(bf16_t, WS_WINB) + (size_t)j * 6144 * 1024, 0, 6144, 1, bid, G, TE); }
            SEAM();
            if (RUN_PHASE) { KArgs* A = ka_ptr();
                const float* wsp = A->in[13] + (size_t)j * 8 * 128 * 128; const float* bsp = A->in[14] + j * 8 * 128;
                const float* lng = A->in[11] + j * 2048; const float* lnb = A->in[12] + j * 2048;
                const bf16_t* Vb = WSP(bf16_t, WS_V); const bf16_t* Ub = WSP(bf16_t, WS_U); bf16_t* A2 = WSP(bf16_t, WS_A2);
                for (int it = bid; it < NB * 16 * 8; it += G) spatial_item(lds, wave, it, wsp, bsp, Vb, Ub, A2, WSP(float, WS_LNST), lng, lnb, A->out + OUT_CVP + (size_t)j * NB * 128 * 2048);
                const int lane = lane_id_v();
                for (int r = gw; r < NSMP; r += NGW) { const size_t ro = (size_t)(MP + r) * 2048;
                    ln_gate_sample_row(Vb + ro, Ub + ro, A2 + ro, lng, lnb, wsp, bsp, A->out + OUT_CVS + ((size_t)j * NSMP + r) * 2048, lane); }
            }
            SEAM();
        }
        if (RUN_PHASE) { KArgs* A = ka_ptr(); pg8::Gemm g{WSP(bf16_t, WS_A2), ((li & 1) ? WSP(bf16_t, WS_WOUTB) : WSP(bf16_t, WS_WOUTA)) + (size_t)j * 1024 * 2048, 0, 0}; pg8::Order S; S.init(MP, 1024, 1, G, bid);
            pg8::EpiRes E{li == 0 ? A->in[0] : nullptr, WSP(bf16_t, WS_HB), WSP(bf16_t, WS_HBA), WSP(float, WS_SSPA)}; pg8::gemm_phase<2048>(lds, wave, g, S, E);
            TEpiRes TE{li == 0 ? A->in[1] - (size_t)MP * 1024 : nullptr, WSP(bf16_t, WS_HB), WSP(bf16_t, WS_HBA), WSP(float, WS_SSSA)}; thin_gemm<2048, 1, 2>(lds, wave, WSP(bf16_t, WS_A2) + (size_t)MP * 2048, 0, ((li & 1) ? WSP(bf16_t, WS_WOUTB) : WSP(bf16_t, WS_WOUTA)) + (size_t)j * 1024 * 2048, 0, 1024, 1, bid, G, TE); }
        SEAM();
        if (RUN_PHASE) { KArgs* A = ka_ptr(); pg8::Gemm g{WSP(bf16_t, WS_HBA), WSP(bf16_t, WS_WG) + (size_t)li * 1024 * 1024, 0, 0}; pg8::Order S; S.init(MP, 1024, 1, G, bid);
            pg8::EpiGate E{WSP(bf16_t, WS_HBA), WSP(bf16_t, WS_PLE) + (size_t)li * MPAD * 1024, WSP(float, WS_SSPA), WSP(bf16_t, WS_HB), WSP(float, WS_H), WSP(float, WS_SSPB)}; pg8::gemm_phase<1024>(lds, wave, g, S, E);
            TEpiGate TE{WSP(bf16_t, WS_HBA), WSP(bf16_t, WS_PLE) + (size_t)li * MPAD * 1024, WSP(float, WS_SSSA), WSP(bf16_t, WS_HB), WSP(float, WS_H), WSP(float, WS_SSSB)}; thin_gemm<1024, 1, 2>(lds, wave, WSP(bf16_t, WS_HBA) + (size_t)MP * 1024, 0, WSP(bf16_t, WS_WG) + (size_t)li * 1024 * 1024, 0, 1024, 1, bid, G, TE); }
        SEAM();
    }
    if (RUN_PHASE) { KArgs* A = ka_ptr();
        const int lane = lane_id_v();
        for (int m = gw; m < MR; m += NGW) {
            float t = m < MP ? (lane < 16 ? WSP(float, WS_SSPB)[(size_t)m * 16 + lane] : 0.f) : WSP(float, WS_SSSB)[(size_t)(m - MP) * 64 + lane];
            const float rs = 1.0f / sqrtf(wave_sum(t) * (1.0f / 1024.0f) + EPS);
            const u32x2* hb = (const u32x2*)(WSP(bf16_t, WS_HB) + (size_t)m * 1024); const f32x4* gf = (const f32x4*)A->in[19]; f32x4* yo = (f32x4*)(A->out + OUT_Y + (size_t)m * 1024);
#pragma unroll
            for (int jq = 0; jq < 4; ++jq) { const u32x2 h = hb[lane + 64 * jq]; const f32x4 g4 = gf[lane + 64 * jq];
                yo[lane + 64 * jq] = (f32x4){bf_lo(h.x) * rs * g4[0], bf_hi(h.x) * rs * g4[1], bf_lo(h.y) * rs * g4[2], bf_hi(h.y) * rs * g4[3]}; }
        }
    }
    SEAM();
#undef RUN_PHASE
#undef SEAM
}

extern "C" void kernel_launch(void* const* d_in, const int* in_sizes, int n_in, void* d_out, int out_size, void* d_ws, size_t ws_size, hipStream_t stream) {
    static int grid = 0;
    if (grid == 0) {
        if (n_in != 20 || (size_t)out_size != OUT_END || ws_size < WS_END) { fprintf(stderr, "kernel_launch: unexpected shapes (n_in %d, out %d, ws %zu; need %zu)\n", n_in, out_size, ws_size, (size_t)WS_END); grid = -1; return; }
        int dev = 0, cus = 0, per_cu = 0;
        (void)hipGetDevice(&dev); (void)hipDeviceGetAttribute(&cus, hipDeviceAttributeMultiprocessorCount, dev);
        if (hipFuncSetAttribute((const void*)fwd_kernel, hipFuncAttributeMaxDynamicSharedMemorySize, LDS_BYTES) != hipSuccess) { fprintf(stderr, "kernel_launch: hipFuncSetAttribute failed\n"); grid = -1; return; }
        if (hipOccupancyMaxActiveBlocksPerMultiprocessor(&per_cu, (const void*)fwd_kernel, NTHREADS, LDS_BYTES) != hipSuccess || per_cu < 1) { fprintf(stderr, "kernel_launch: occupancy query gave %d\n", per_cu); per_cu = 1; }
        (void)hipGetLastError();
        grid = cus * per_cu;
    }
    if (grid < 0) return;
    if (hipMemsetAsync((char*)d_ws + WS_CTR, 0, 16384, stream) != hipSuccess) { fprintf(stderr, "kernel_launch: memset of the barrier words failed\n"); return; }
    Args a{};
    for (int i = 0; i < 20; ++i) a.in[i] = (const float*)d_in[i];
    a.out = (float*)d_out; a.ws = (unsigned char*)d_ws;
#if N_LAUNCH_MODE == 1
    a.ph_lo = 0; a.ph_hi = N_PHASES;
    void* kargs[] = {&a};
    hipError_t e = hipLaunchCooperativeKernel((const void*)fwd_kernel, dim3(grid), dim3(NTHREADS), kargs, LDS_BYTES, stream);
    if (e != hipSuccess) fprintf(stderr, "kernel_launch: cooperative launch failed: %s (grid %d)\n", hipGetErrorString(e), grid);
#else
    for (int p = 0; p < N_PHASES; ++p) { a.ph_lo = p; a.ph_hi = p + 1; hipLaunchKernelGGL(fwd_kernel, dim3(grid), dim3(NTHREADS), LDS_BYTES, stream, a); }
#endif
}
```
